# Optimizing an MI355X kernel written in HIP

```python
import jax, jax.numpy as jnp
from jax import lax
import numpy as np

D_MODEL = 1024
BATCH = 4
SEQ = 8192
DEPTH = 2

MIX_WIDTH = (3 * D_MODEL) // 4
MEM_WIDTH = D_MODEL // 4
N_MEM = 256
MEM_HEADS = 4
MEM_HEAD_DIM = MEM_WIDTH // MEM_HEADS
CHUNK = 128
SG_GROUPS = 8
SG_GROUP_DIM = MIX_WIDTH // SG_GROUPS
RET_CHUNK = 128
RET_HEADS = 4
RET_V_DIM = MIX_WIDTH // RET_HEADS
RET_QK_DIM = RET_V_DIM // 2
ROPE_BASE = 10000.0
D_FF = 2816
N_EXPERTS = 8
TOP_K = 2
D_FF_EXPERT = 3584
MOE_BLOCK = 128
N_A = (DEPTH + 1) // 2
N_B = DEPTH // 2
DEEPNORM_ALPHA = (2.0 * DEPTH) ** 0.25
DEEPNORM_BETA = (8.0 * DEPTH) ** -0.25
LN_EPS = 1e-5

kernel_name = 'hybrid_sgmlp_retention_moe_encoder'


def layer_norm(x, g, b):
    xf = x.astype(jnp.float32)
    mu = jnp.mean(xf, -1, keepdims=True)
    var = jnp.mean(jnp.square(xf - mu), -1, keepdims=True)
    return ((xf - mu) * lax.rsqrt(var + LN_EPS)).astype(x.dtype) * g + b


def head_norm(o):
    mu = jnp.mean(o, -1, keepdims=True)
    var = jnp.mean(jnp.square(o - mu), -1, keepdims=True)
    on = (o - mu) * lax.rsqrt(var + LN_EPS)
    return on.reshape(o.shape[0], o.shape[1], -1)


def rope_tables(seq, dim):
    inv = ROPE_BASE ** (-jnp.arange(0, dim, 2, dtype=jnp.float32) / dim)
    ang = jnp.arange(seq, dtype=jnp.float32)[:, None] * inv[None, :]
    return jnp.cos(ang), jnp.sin(ang)


def apply_rope(t, cos, sin):
    half = t.shape[-1] // 2
    t1, t2 = t[..., :half], t[..., half:]
    c = cos[None, :, None, :]
    s = sin[None, :, None, :]
    return jnp.concatenate([t1 * c - t2 * s, t2 * c + t1 * s], axis=-1)


def memory_attention(mq, mem_k, mem_v):
    b, s, _ = mq.shape
    q = mq.reshape(b, s, MEM_HEADS, MEM_HEAD_DIM)
    scores = jnp.einsum('bshd,bmhd->bhsm', q, mem_k).astype(jnp.float32) * (MEM_HEAD_DIM ** -0.5)
    probs = jax.nn.softmax(scores, axis=-1).astype(mem_v.dtype)
    return jnp.einsum('bhsm,bmhd->bshd', probs, mem_v).reshape(b, s, MEM_WIDTH)


def spatial_gating(u, v, ln_g, ln_b, w_s, b_s):
    b, s, _ = v.shape
    v = layer_norm(v, ln_g, ln_b).reshape(b, s // CHUNK, CHUNK, SG_GROUPS, SG_GROUP_DIM)
    mixed = jnp.einsum('gpq,bnqgd->bnpgd', w_s, v) + b_s.T[:, :, None]
    return u * mixed.reshape(b, s, MIX_WIDTH)


def chunk_scan(qd, kd, vc, chunk_decay, reverse):
    b, _, _, h, dk = qd.shape
    dv = vc.shape[-1]

    def step(state, xs):
        qn, kn, vn = xs
        out = jnp.einsum('bihd,bhde->bihe', qn, state)
        state = state * chunk_decay[None, :, None, None] + jnp.einsum('bjhd,bjhe->bhde', kn, vn)
        return state, out

    xs = (jnp.moveaxis(qd, 1, 0), jnp.moveaxis(kd, 1, 0), jnp.moveaxis(vc, 1, 0))
    init = jnp.zeros((b, h, dk, dv), jnp.float32)
    _, out = lax.scan(step, init, xs, reverse=reverse)
    return jnp.moveaxis(out, 0, 1)


def bidirectional_retention(q, k, v, log_gf, log_gb):
    b, s, h, dk = q.shape
    dv = v.shape[-1]
    nc = s // RET_CHUNK
    pos = jnp.arange(RET_CHUNK, dtype=jnp.float32)
    qc = (q * dk ** -0.5).reshape(b, nc, RET_CHUNK, h, dk)
    kc = k.reshape(b, nc, RET_CHUNK, h, dk)
    vc = v.reshape(b, nc, RET_CHUNK, h, dv)
    diff = pos[:, None] - pos[None, :]
    expo = jnp.where(diff[None] >= 0, diff[None] * log_gf[:, None, None], -diff[None] * log_gb[:, None, None])
    decay_mask = jnp.exp(expo)
    scores = jnp.einsum('bnihd,bnjhd->bnhij', qc, kc) * decay_mask
    o_inner = jnp.einsum('bnhij,bnjhe->bnihe', scores, vc)
    q_f = qc * jnp.exp(pos[:, None] * log_gf)[:, :, None]
    k_f = kc * jnp.exp((RET_CHUNK - pos)[:, None] * log_gf)[:, :, None]
    o_f = chunk_scan(q_f, k_f, vc, jnp.exp(RET_CHUNK * log_gf), reverse=False)
    q_b = qc * jnp.exp((RET_CHUNK - 1 - pos)[:, None] * log_gb)[:, :, None]
    k_b = kc * jnp.exp((pos + 1)[:, None] * log_gb)[:, :, None]
    o_b = chunk_scan(q_b, k_b, vc, jnp.exp(RET_CHUNK * log_gb), reverse=True)
    return (o_inner + o_f + o_b).reshape(b, s, h, dv)


def dense_swiglu(x, wg, wu, wd):
    return (jax.nn.silu(x @ wg) * (x @ wu)) @ wd


def moe_swiglu(x, w_router, b_router, w_gate, w_up, w_down):
    b, s, d = x.shape
    xt = x.reshape(-1, d)
    n_tok = xt.shape[0]
    n_asg = n_tok * TOP_K
    logits = (xt @ w_router).astype(jnp.float32) + b_router.astype(jnp.float32)
    top_logit, top_idx = lax.top_k(logits, TOP_K)
    gate = jax.nn.softmax(top_logit, axis=-1)
    exp_id = top_idx.reshape(-1)
    tok_id = jnp.arange(n_asg) // TOP_K
    order = jnp.argsort(exp_id)
    sorted_exp = exp_id[order]
    counts = jnp.bincount(exp_id, length=N_EXPERTS)
    padded = (counts + MOE_BLOCK - 1) // MOE_BLOCK * MOE_BLOCK
    pad_end = jnp.cumsum(padded)
    pad_start = pad_end - padded
    grp_start = jnp.cumsum(counts) - counts
    dest = pad_start[sorted_exp] + (jnp.arange(n_asg) - grp_start[sorted_exp])
    n_rows = n_asg + N_EXPERTS * MOE_BLOCK
    n_blocks = n_rows // MOE_BLOCK
    sorted_tok = tok_id[order]
    buf = jnp.zeros((n_rows, d), x.dtype).at[dest].set(xt[sorted_tok])
    blk_exp = jnp.minimum(jnp.searchsorted(pad_end, jnp.arange(n_blocks) * MOE_BLOCK, side='right'), N_EXPERTS - 1)

    def expert_block(args):
        xb, e = args
        return (jax.nn.silu(xb @ w_gate[e]) * (xb @ w_up[e])) @ w_down[e]

    yb = lax.map(expert_block, (buf.reshape(n_blocks, MOE_BLOCK, d), blk_exp))
    y_rows = yb.reshape(n_rows, d)[dest]
    w = gate.reshape(-1)[order].astype(x.dtype)
    y = jax.ops.segment_sum(y_rows * w[:, None], sorted_tok, num_segments=n_tok)
    return y.reshape(b, s, d)


def setup_inputs(seed: int = 0) -> dict:
    key = jax.random.key(seed)
    ks = iter(jax.random.split(key, 32))
    f32 = jnp.float32

    def dense(shape, fan_in, scale=1.0):
        return jax.random.normal(next(ks), shape, f32) * (scale * fan_in ** -0.5)

    def gain(shape):
        return 1.0 + 0.02 * jax.random.normal(next(ks), shape, f32)

    def small(shape, scale=0.02):
        return scale * jax.random.normal(next(ks), shape, f32)

    gam = 1.0 - 2.0 ** (-5.0 - jnp.arange(RET_HEADS, dtype=f32))
    decay_base = jnp.log(gam) - jnp.log1p(-gam)
    n_in_b = 2 * RET_HEADS * RET_QK_DIM + 2 * MIX_WIDTH + MEM_WIDTH
    return {
        'x': jax.random.normal(next(ks), (BATCH, SEQ, D_MODEL), f32),
        'mem': jax.random.normal(next(ks), (BATCH, N_MEM, D_MODEL), f32),
        'w_mem_kv': dense((D_MODEL, 2 * MEM_WIDTH), D_MODEL),
        'w_in_a': dense((N_A, D_MODEL, 2 * MIX_WIDTH + MEM_WIDTH), D_MODEL),
        'sg_ln_g': gain((N_A, MIX_WIDTH)),
        'sg_ln_b': small((N_A, MIX_WIDTH)),
        'sg_w': dense((N_A, SG_GROUPS, CHUNK, CHUNK), CHUNK, 0.5),
        'sg_b': gain((N_A, SG_GROUPS, CHUNK)),
        'w_in_b': dense((N_B, D_MODEL, n_in_b), D_MODEL),
        'decay_logit_f': decay_base + small((N_B, RET_HEADS), 0.1),
        'decay_logit_b': decay_base + small((N_B, RET_HEADS), 0.1),
        'ret_gn_g': gain((N_B, MIX_WIDTH)),
        'ret_gn_b': small((N_B, MIX_WIDTH)),
        'w_out': dense((DEPTH, D_MODEL, D_MODEL), D_MODEL, DEEPNORM_BETA),
        'ln_g': gain((DEPTH, 2, D_MODEL)),
        'ln_b': small((DEPTH, 2, D_MODEL)),
        'w_ff_gate': dense((N_A, D_MODEL, D_FF), D_MODEL),
        'w_ff_up': dense((N_A, D_MODEL, D_FF), D_MODEL),
        'w_ff_down': dense((N_A, D_FF, D_MODEL), D_FF, DEEPNORM_BETA),
        'w_router': dense((N_B, D_MODEL, N_EXPERTS), D_MODEL),
        'b_router': small((N_B, N_EXPERTS), 0.01),
        'w_e_gate': dense((N_B, N_EXPERTS, D_MODEL, D_FF_EXPERT), D_MODEL),
        'w_e_up': dense((N_B, N_EXPERTS, D_MODEL, D_FF_EXPERT), D_MODEL),
        'w_e_down': dense((N_B, N_EXPERTS, D_FF_EXPERT, D_MODEL), D_FF_EXPERT, DEEPNORM_BETA),
    }


def reference(x, mem, w_mem_kv, w_in_a, sg_ln_g, sg_ln_b, sg_w, sg_b, w_in_b, decay_logit_f, decay_logit_b, ret_gn_g, ret_gn_b, w_out, ln_g, ln_b, w_ff_gate, w_ff_up, w_ff_down, w_router, b_router, w_e_gate, w_e_up, w_e_down):
    b, s, _ = x.shape
    f32 = jnp.float32
    mem_k, mem_v = jnp.split(mem @ w_mem_kv, 2, axis=-1)
    mem_k = mem_k.reshape(b, N_MEM, MEM_HEADS, MEM_HEAD_DIM)
    mem_v = mem_v.reshape(b, N_MEM, MEM_HEADS, MEM_HEAD_DIM)
    cos, sin = rope_tables(s, RET_QK_DIM)
    qk_w = RET_HEADS * RET_QK_DIM
    for i in range(DEPTH):
        j = i // 2
        if i % 2 == 0:
            h = x @ w_in_a[j]
            u, v, mq = jnp.split(h, [MIX_WIDTH, 2 * MIX_WIDTH], axis=-1)
            mix = spatial_gating(jax.nn.gelu(u, approximate=False), jax.nn.gelu(v, approximate=False),
                                 sg_ln_g[j], sg_ln_b[j], sg_w[j], sg_b[j])
        else:
            h = x @ w_in_b[j]
            q, k, v, g, mq = jnp.split(h, [qk_w, 2 * qk_w, 2 * qk_w + MIX_WIDTH, 2 * qk_w + 2 * MIX_WIDTH], axis=-1)
            q = apply_rope(q.reshape(b, s, RET_HEADS, RET_QK_DIM).astype(f32), cos, sin)
            k = apply_rope(k.reshape(b, s, RET_HEADS, RET_QK_DIM).astype(f32), cos, sin)
            v = v.reshape(b, s, RET_HEADS, RET_V_DIM).astype(f32)
            log_gf = jax.nn.log_sigmoid(decay_logit_f[j].astype(f32))
            log_gb = jax.nn.log_sigmoid(decay_logit_b[j].astype(f32))
            o = bidirectional_retention(q, k, v, log_gf, log_gb)
            o = head_norm(o).astype(x.dtype) * ret_gn_g[j] + ret_gn_b[j]
            mix = jax.nn.silu(g) * o
        y = jnp.concatenate([mix, memory_attention(mq, mem_k, mem_v)], axis=-1) @ w_out[i]
        x = layer_norm(DEEPNORM_ALPHA * x + y, ln_g[i, 0], ln_b[i, 0])
        if i % 2 == 0:
            f = dense_swiglu(x, w_ff_gate[j], w_ff_up[j], w_ff_down[j])
        else:
            f = moe_swiglu(x, w_router[j], b_router[j], w_e_gate[j], w_e_up[j], w_e_down[j])
        x = layer_norm(DEEPNORM_ALPHA * x + f, ln_g[i, 1], ln_b[i, 1])
    return x
```

```cpp
#include <hip/hip_runtime.h>
#include <cstdio>
#include <cstdint>
#include <cmath>
namespace pg8 {
#define PG8_LAS __attribute__((address_space(3)))
typedef unsigned short bf16_t;
typedef short bf16x8 __attribute__((ext_vector_type(8)));
typedef float f32x4 __attribute__((ext_vector_type(4)));
typedef unsigned u32x4 __attribute__((ext_vector_type(4)));
constexpr int BM = 256, BK = 64, HALF = 128, HTB = HALF * BK * 2  , STAGE_BYTES = 8 * HTB, NXCD = 8, WGM = 8;

__host__ __device__ __forceinline__ int lds_byte(int r, int c) { const int st = (r >> 4) * 2 + (c >> 5), rr = r & 15, cc = c & 31, ob = rr * 64 + cc * 2; return st * 1024 + (ob ^ (((ob >> 9) & 1) << 5)); }
__host__ __device__ __forceinline__ void stage_rc(int b, int& R, int& C) { const int st = b / 1024, sb = b % 1024, swz = sb ^ (((sb >> 9) & 1) << 5); R = (st >> 1) * 16 + swz / 64; C = (st & 1) * 32 + (swz % 64) / 2; }
__host__ __device__ __forceinline__ int perm32(int rho) { const int n = rho >> 4, i = rho & 15; return 8 * (i >> 2) + 4 * n + (i & 3); }

struct Unit { int pm, pn; };
struct Gemm { const bf16_t* A; const bf16_t* Bt; int M, N, K; };

struct StaticOrder {
    int nM, nN, nwg, G, c;
    __host__ __device__ void init(int M, int N, int G_, int c_) { nM = M / BM; nN = N / BM; nwg = nM * nN; G = G_; c = c_; }
    __host__ __device__ bool next(int i, Unit& u) const {
        const long L = (long)i * G + c; if (L >= nwg) return false;
        int wgid = (int)L; { const int q = nwg / NXCD, r = nwg % NXCD, xcd = wgid % NXCD, off = wgid / NXCD; wgid = (xcd < r ? xcd * (q + 1) : r * (q + 1) + (xcd - r) * q) + off; }
        const int nig = WGM * nN, gid = wgid / nig, fm = gid * WGM, gsz = (nM - fm) < WGM ? (nM - fm) : WGM;
        u.pm = fm + ((wgid % nig) % gsz); u.pn = (wgid % nig) / gsz; return true;
    }
    __device__ __forceinline__ int btile(const Unit& u) const { return u.pn; }
    __device__ __forceinline__ void a_ready(const Unit&) const {}
    __device__ __forceinline__ void done(const Unit&) const {}
};

__device__ __forceinline__ unsigned cvt_pk_bf16(float lo, float hi) { unsigned r; asm volatile("v_cvt_pk_bf16_f32 %0, %1, %2" : "=v"(r) : "v"(lo), "v"(hi)); return r; }
typedef float f32x2 __attribute__((ext_vector_type(2)));
__device__ __forceinline__ f32x2 gelu_pk(f32x2 v) {
    const f32x2 av = __builtin_elementwise_abs(v), d = av * 0.2316418882f + 1.0f;
    f32x2 t; t.x = __builtin_amdgcn_rcpf(d.x); t.y = __builtin_amdgcn_rcpf(d.y);
    f32x2 q = t * 0.5307027145f + (-0.7265760135f); q = q * t + 0.7107068705f; q = q * t + (-0.142248368f); q = q * t + 0.127414796f; q = q * t;
    const f32x2 s = (v * v) * (-0.72134752044f);
    f32x2 e; e.x = __builtin_amdgcn_exp2f(s.x); e.y = __builtin_amdgcn_exp2f(s.y);
    const f32x2 m = v * (q * e), r = v - m;
    f32x2 o; o.x = v.x < 0.f ? m.x : r.x; o.y = v.y < 0.f ? m.y : r.y; return o;
}
__device__ __forceinline__ float silu_f(float x) { return x * __builtin_amdgcn_rcpf(1.0f + __builtin_amdgcn_exp2f(-1.44269504089f * x)); }
struct EpiAct {
    static constexpr bool PERM = true, AFTER_DRAIN = false;
    bf16_t* O; int ldc; int ngelu; int row_off;
    __device__ __forceinline__ void operator()(const f32x4 (&acc)[2][2][4][2], const Unit& u, int wr, int wc, int fr, int fq) const {
        const int row0 = row_off + u.pm * BM + wr * 64 + fr, col0 = u.pn * BM + wc * 32 + 8 * fq;
        const bool act = u.pn < ngelu;
#pragma unroll
        for (int ai = 0; ai < 2; ++ai)
#pragma unroll
            for (int m = 0; m < 4; ++m) { bf16_t* rowp = O + (size_t)(row0 + ai * HALF + m * 16) * ldc + col0;
#pragma unroll
                for (int bj = 0; bj < 2; ++bj) { f32x4 v0 = acc[ai][bj][m][0], v1 = acc[ai][bj][m][1];
                    if (act) { f32x2 a = gelu_pk((f32x2){v0[0], v0[1]}), b = gelu_pk((f32x2){v0[2], v0[3]}), c = gelu_pk((f32x2){v1[0], v1[1]}), d = gelu_pk((f32x2){v1[2], v1[3]});
                        v0 = (f32x4){a.x, a.y, b.x, b.y}; v1 = (f32x4){c.x, c.y, d.x, d.y}; }
                    u32x4 w; w.x = cvt_pk_bf16(v0[0], v0[1]); w.y = cvt_pk_bf16(v0[2], v0[3]); w.z = cvt_pk_bf16(v1[0], v1[1]); w.w = cvt_pk_bf16(v1[2], v1[3]);
                    *(u32x4*)(rowp + bj * HALF) = w; } }
    }
};
struct EpiSwiglu {
    static constexpr bool PERM = true, AFTER_DRAIN = false;
    bf16_t* O; int ldc;
    __device__ __forceinline__ void operator()(const f32x4 (&acc)[2][2][4][2], const Unit& u, int wr, int wc, int fr, int fq) const {
        const int row0 = u.pm * BM + wr * 64 + fr, col0 = u.pn * HALF + wc * 32 + 8 * fq;
#pragma unroll
        for (int ai = 0; ai < 2; ++ai)
#pragma unroll
            for (int m = 0; m < 4; ++m) { bf16_t* rowp = O + (size_t)(row0 + ai * HALF + m * 16) * ldc + col0;
                const f32x4 g0 = acc[ai][0][m][0], g1 = acc[ai][0][m][1], u0 = acc[ai][1][m][0], u1 = acc[ai][1][m][1];
                u32x4 w; w.x = cvt_pk_bf16(silu_f(g0[0]) * u0[0], silu_f(g0[1]) * u0[1]); w.y = cvt_pk_bf16(silu_f(g0[2]) * u0[2], silu_f(g0[3]) * u0[3]);
                w.z = cvt_pk_bf16(silu_f(g1[0]) * u1[0], silu_f(g1[1]) * u1[1]); w.w = cvt_pk_bf16(silu_f(g1[2]) * u1[2], silu_f(g1[3]) * u1[3]);
                *(u32x4*)rowp = w; }
    }
};
template <bool BASE_BF16> struct EpiZ {
    static constexpr bool PERM = false, AFTER_DRAIN = false;
    const void* base; float* Z; float alpha;
    __device__ __forceinline__ void operator()(const f32x4 (&acc)[2][2][4][2], const Unit& u, int wr, int wc, int fr, int fq) const {
        const int row0 = u.pm * BM + wr * 64 + fr, col0 = u.pn * BM + wc * 32 + 4 * fq;
#pragma unroll
        for (int ai = 0; ai < 2; ++ai)
#pragma unroll
            for (int m = 0; m < 4; ++m) { const size_t off = (size_t)(row0 + ai * HALF + m * 16) * 1024 + col0;
#pragma unroll
                for (int bj = 0; bj < 2; ++bj)
#pragma unroll
                    for (int n = 0; n < 2; ++n) { const size_t o2 = off + bj * HALF + n * 16; f32x4 b;
                        if (BASE_BF16) { const uint2 r = *(const uint2*)((const bf16_t*)base + o2); b = (f32x4){__uint_as_float(r.x << 16), __uint_as_float(r.x & 0xffff0000u), __uint_as_float(r.y << 16), __uint_as_float(r.y & 0xffff0000u)}; }
                        else b = *(const f32x4*)((const float*)base + o2);
                        *(f32x4*)(Z + o2) = b * alpha + acc[ai][bj][m][n]; } }
    }
};
struct MoeOrder : StaticOrder {
    const int* pe; int nbt;
    __device__ __forceinline__ int btile(const Unit& u) const { return pe[u.pm] * nbt + u.pn; }
};
template <class Epi, class Sched, bool ALIGN_EPI = false, bool SP2 = false>
__device__ __forceinline__ void gemm_phase(PG8_LAS unsigned char* lds, const Gemm g, const Sched& S, const Epi& E) {
    const int tid = threadIdx.x, wid = __builtin_amdgcn_readfirstlane(tid >> 6), lane = tid & 63, wr = wid >> 2, wc = wid & 3, fr = lane & 15, fq = lane >> 4;
    const int K = g.K, nt = K / BK;
    unsigned voffA[2], voffB[2];
#pragma unroll
    for (int i = 0; i < 2; ++i) { int R, C; stage_rc(tid * 16 + i * 8192, R, C); const int Rb = Epi::PERM ? ((R & ~31) + perm32(R & 31)) : R;
        voffA[i] = (unsigned)(R * K + C) * 2u; voffB[i] = (unsigned)(Rb * K + C) * 2u; }
    const size_t kstep = (size_t)(BK * 2);
    const size_t hstep = (size_t)HALF * K * 2;
    const size_t tstep = 2 * hstep;
    const unsigned ldsw = (unsigned)wid * 1024u;
    const int aoff = lds_byte(wr * 64 + fr, fq * 8), boff = lds_byte(wc * 32 + fr, fq * 8);
#define PG8_SA(b, h) (((b) * 2 + (h)) * HTB)
#define PG8_SB(b, h) ((4 + (b) * 2 + (h)) * HTB)
#define PG8_STAGE(bufoff, gbase, voff) do { _Pragma("unroll") for (int _i = 0; _i < 2; ++_i) \
        __builtin_amdgcn_global_load_lds((const unsigned*)((const char*)(gbase) + (voff)[_i]), (PG8_LAS unsigned*)(lds + (bufoff) + ldsw + _i * 8192), 16, 0, 0); } while (0)
#define PG8_LDA(dst, b, h) do { _Pragma("unroll") for (int m = 0; m < 4; ++m) _Pragma("unroll") for (int k = 0; k < 2; ++k) dst[m][k] = *(const PG8_LAS bf16x8*)(lds + PG8_SA(b, h) + aoff + m * 2048 + k * 1024); } while (0)
#define PG8_LDB(dst, b, h) do { _Pragma("unroll") for (int n = 0; n < 2; ++n) _Pragma("unroll") for (int k = 0; k < 2; ++k) dst[n][k] = *(const PG8_LAS bf16x8*)(lds + PG8_SB(b, h) + boff + n * 2048 + k * 1024); } while (0)
#define PG8_MMA(ai, bj, At, Bt) do { __builtin_amdgcn_s_setprio(1); _Pragma("unroll") for (int m = 0; m < 4; ++m) _Pragma("unroll") for (int n = 0; n < 2; ++n) _Pragma("unroll") for (int k = 0; k < 2; ++k) \
        acc[ai][bj][m][n] = __builtin_amdgcn_mfma_f32_16x16x32_bf16(Bt[n][k], At[m][k], acc[ai][bj][m][n], 0, 0, 0); __builtin_amdgcn_s_setprio(0); } while (0)
#define PG8_WAIT_V(n) asm volatile("s_waitcnt vmcnt(" #n ")" ::: "memory")
#define PG8_WAIT_L(n) asm volatile("s_waitcnt lgkmcnt(" #n ")" ::: "memory")
#define PG8_BAR __builtin_amdgcn_s_barrier()
#define PG8_SCHED __builtin_amdgcn_sched_barrier(0)
    Unit cur, nxt; int ui = 0;
    if (!S.next(0, cur)) return;
    f32x4 acc[2][2][4][2];
#pragma unroll
    for (int a = 0; a < 2; ++a)
#pragma unroll
        for (int b = 0; b < 2; ++b)
#pragma unroll
            for (int m = 0; m < 4; ++m)
#pragma unroll
                for (int n = 0; n < 2; ++n) acc[a][b][m][n] = (f32x4){0.f, 0.f, 0.f, 0.f};
    bf16x8 At[4][2], B0[2][2], B1[2][2];
    const char* cA = (const char*)g.A + (size_t)cur.pm * tstep; const char* cB = (const char*)g.Bt + (size_t)S.btile(cur) * tstep;
    S.a_ready(cur);
    if constexpr (SP2) {
        PG8_STAGE(PG8_SB(0, 0), cB, voffB); PG8_STAGE(PG8_SB(0, 1), cB + hstep, voffB); PG8_STAGE(PG8_SA(0, 0), cA, voffA); PG8_STAGE(PG8_SA(0, 1), cA + hstep, voffA);
        if (wr == 1) PG8_BAR;
        PG8_WAIT_V(2); PG8_BAR;
        PG8_STAGE(PG8_SB(1, 0), cB + kstep, voffB); PG8_STAGE(PG8_SA(1, 0), cA + kstep, voffA); PG8_STAGE(PG8_SB(1, 1), cB + hstep + kstep, voffB);
        PG8_WAIT_V(6); PG8_BAR;
    } else {
        PG8_STAGE(PG8_SB(0, 0), cB, voffB); PG8_STAGE(PG8_SA(0, 0), cA, voffA); PG8_STAGE(PG8_SB(0, 1), cB + hstep, voffB); PG8_STAGE(PG8_SA(0, 1), cA + hstep, voffA);
        if (wr == 1) PG8_BAR;
        PG8_WAIT_V(4); PG8_BAR;
        PG8_STAGE(PG8_SB(1, 0), cB + kstep, voffB); PG8_STAGE(PG8_SA(1, 0), cA + kstep, voffA); PG8_STAGE(PG8_SB(1, 1), cB + hstep + kstep, voffB);
        PG8_WAIT_V(6); PG8_BAR;
    }
    for (;;) {
        const bool has_next = S.next(ui + 1, nxt);
        const char* nA = has_next ? (const char*)g.A + (size_t)nxt.pm * tstep : cA; const char* nB = has_next ? (const char*)g.Bt + (size_t)S.btile(nxt) * tstep : cB;
        for (int t = 0; t < nt; t += 2) {
            const bool last = (t == nt - 2);
            const char* a1 = cA + (size_t)(t + 1) * kstep;
            const char* a2 = last ? nA : cA + (size_t)(t + 2) * kstep; const char* b2 = last ? nB : cB + (size_t)(t + 2) * kstep;
            const char* a3 = a2 + kstep; const char* b3 = b2 + kstep;
            if (last && has_next) S.a_ready(nxt);
            if constexpr (SP2) {
            PG8_LDB(B0, 0, 0); PG8_LDB(B1, 0, 1); PG8_SCHED; PG8_LDA(At, 0, 0); PG8_STAGE(PG8_SA(1, 1), a1 + hstep, voffA);
            PG8_WAIT_V(8); PG8_WAIT_L(0); PG8_BAR; PG8_MMA(0, 0, At, B0); PG8_MMA(0, 1, At, B1); PG8_BAR; PG8_SCHED;
            PG8_LDA(At, 0, 1); PG8_STAGE(PG8_SB(0, 0), b2, voffB); PG8_STAGE(PG8_SB(0, 1), b2 + hstep, voffB); PG8_STAGE(PG8_SA(0, 0), a2, voffA);
            PG8_WAIT_V(8); PG8_WAIT_L(0); PG8_BAR; PG8_MMA(1, 0, At, B0); PG8_MMA(1, 1, At, B1); PG8_BAR; PG8_SCHED;
            PG8_LDB(B0, 1, 0); PG8_LDB(B1, 1, 1); PG8_SCHED; PG8_LDA(At, 1, 0); PG8_STAGE(PG8_SA(0, 1), a2 + hstep, voffA);
            PG8_WAIT_V(8); PG8_WAIT_L(0); PG8_BAR; PG8_MMA(0, 0, At, B0); PG8_MMA(0, 1, At, B1); PG8_BAR; PG8_SCHED;
            PG8_LDA(At, 1, 1); PG8_STAGE(PG8_SB(1, 0), b3, voffB); PG8_STAGE(PG8_SB(1, 1), b3 + hstep, voffB); PG8_STAGE(PG8_SA(1, 0), a3, voffA);
            PG8_WAIT_V(8); PG8_WAIT_L(0); PG8_BAR; PG8_MMA(1, 0, At, B0); PG8_MMA(1, 1, At, B1); PG8_BAR; PG8_SCHED;
            } else {
            PG8_LDB(B0, 0, 0); PG8_SCHED; PG8_LDA(At, 0, 0); PG8_STAGE(PG8_SA(1, 1), a1 + hstep, voffA);
            PG8_WAIT_L(8); PG8_BAR; PG8_WAIT_L(0); PG8_MMA(0, 0, At, B0); PG8_BAR; PG8_SCHED;
            PG8_LDB(B1, 0, 1); PG8_STAGE(PG8_SB(0, 0), b2, voffB);
            PG8_BAR; PG8_WAIT_L(0); PG8_MMA(0, 1, At, B1); PG8_BAR;
            PG8_LDA(At, 0, 1); PG8_STAGE(PG8_SA(0, 0), a2, voffA);
            PG8_BAR; PG8_WAIT_L(0); PG8_MMA(1, 0, At, B0); PG8_BAR; PG8_SCHED;
            PG8_STAGE(PG8_SB(0, 1), b2 + hstep, voffB);
            PG8_WAIT_V(6); PG8_BAR; PG8_MMA(1, 1, At, B1); PG8_BAR;
            PG8_LDB(B0, 1, 0); PG8_SCHED; PG8_LDA(At, 1, 0); PG8_STAGE(PG8_SA(0, 1), a2 + hstep, voffA);
            PG8_WAIT_L(8); PG8_BAR; PG8_WAIT_L(0); PG8_MMA(0, 0, At, B0); PG8_BAR; PG8_SCHED;
            PG8_LDB(B1, 1, 1); PG8_STAGE(PG8_SB(1, 0), b3, voffB);
            PG8_BAR; PG8_WAIT_L(0); PG8_MMA(0, 1, At, B1); PG8_BAR;
            PG8_LDA(At, 1, 1); PG8_STAGE(PG8_SA(1, 0), a3, voffA);
            PG8_BAR; PG8_WAIT_L(0); PG8_MMA(1, 0, At, B0); PG8_BAR; PG8_SCHED;
            PG8_STAGE(PG8_SB(1, 1), b3 + hstep, voffB);
            PG8_WAIT_V(6); PG8_BAR; PG8_MMA(1, 1, At, B1); PG8_BAR;
            }
        }
        if constexpr (ALIGN_EPI) { if (wr == 0) PG8_BAR; }
        if constexpr (!Epi::AFTER_DRAIN) { E(acc, cur, wr, wc, fr, fq); S.done(cur); }
        if (!has_next) break;
#pragma unroll
        for (int a = 0; a < 2; ++a)
#pragma unroll
            for (int b = 0; b < 2; ++b)
#pragma unroll
                for (int m = 0; m < 4; ++m)
#pragma unroll
                    for (int n = 0; n < 2; ++n) acc[a][b][m][n] = (f32x4){0.f, 0.f, 0.f, 0.f};
        cur = nxt; cA = nA; cB = nB; ++ui;
        if constexpr (ALIGN_EPI) { if (wr == 1) PG8_BAR; }
    }
    PG8_WAIT_V(0);
    if constexpr (!ALIGN_EPI) { if (wr == 0) PG8_BAR; }
    PG8_BAR;
    if constexpr (Epi::AFTER_DRAIN) { E.fused(acc, cur, wr, wc, fr, fq, lds, wid, lane); S.done(cur); }
#undef PG8_SA
#undef PG8_SB
#undef PG8_STAGE
#undef PG8_LDA
#undef PG8_LDB
#undef PG8_MMA
#undef PG8_WAIT_V
#undef PG8_WAIT_L
#undef PG8_BAR
#undef PG8_SCHED
}
}
#define PG8_SP2 true
#define PG8_ALIGN true
constexpr int NWAVES = 8;
#ifndef MK_SINGLE
#define MK_SINGLE 0
#endif

constexpr int BATCH = 4, SEQ = 8192, DM = 1024, NTOK = BATCH * SEQ;
constexpr int MIXW = 768, MEMW = 256, NMEM = 256;
constexpr int NINA = 2 * MIXW + MEMW;
constexpr int QKW = 384, NINB = 2 * QKW + 2 * MIXW + MEMW;
constexpr int DFF = 2816, DFFE = 3584, NEXP = 8;
constexpr int PASS_PANELS = 64, MAX_PANELS = 264, MAX_PASSES = 5;
constexpr float LN_EPS = 1e-5f, ALPHA = 1.41421356237f;

constexpr size_t MiB = 1u << 20, KiB = 1u << 10;
constexpr size_t WS_CTL = 0, CTL_ZERO_BYTES = 1 * MiB;
constexpr size_t WS_ROPEC = 1 * MiB, WS_ROPES = 2 * MiB + 512 * KiB;
constexpr size_t WS_MEMK = 4 * MiB, WS_MEMVT = 4 * MiB + 512 * KiB;
constexpr size_t WS_SGWB = 5 * MiB;
constexpr size_t WS_TOPI = 5 * MiB + 256 * KiB, WS_GATE = 5 * MiB + 512 * KiB, WS_DEST = 5 * MiB + 768 * KiB, WS_ROWTOK = 6 * MiB;
constexpr size_t WS_PRM = 6 * MiB + 512 * KiB;
constexpr size_t WS_WINA = 7 * MiB, WS_WINB = WS_WINA + 3 * MiB + 512 * KiB, WS_WOUT = WS_WINB + 5 * MiB, WS_WFFGU = WS_WOUT + 4 * MiB, WS_WFFD = WS_WFFGU + 11 * MiB,
                 WS_WEGU = WS_WFFD + 5 * MiB + 512 * KiB, WS_WED = WS_WEGU + 112 * MiB, WS_ACT = WS_WED + 56 * MiB;
static_assert(WS_ACT == 204 * MiB, "weights map");
constexpr size_t WS_XB = WS_ACT, WS_H0 = WS_ACT + 64 * MiB, WS_CAT0 = WS_ACT + 176 * MiB, WS_X1 = WS_ACT + 240 * MiB;
constexpr size_t WS_HID = WS_ACT, WS_X2 = WS_ACT + 176 * MiB;
constexpr size_t WS_H1 = WS_ACT, WS_CAT1 = WS_ACT + 240 * MiB;
constexpr size_t WS_X3 = WS_ACT, WS_XG = WS_ACT + 64 * MiB, WS_YR = WS_ACT + 96 * MiB;
constexpr size_t WS_END = WS_ACT + 304 * MiB;
static_assert(WS_YR + (size_t)MAX_PANELS * 256 * DM * 2 <= WS_END && WS_HID + (size_t)NTOK * DFF * 2 <= WS_X2 && WS_H1 + (size_t)NTOK * NINB * 2 <= WS_CAT1, "d_ws map");
constexpr int CW_TMO = 0, CW_CODE = 1;
constexpr int CW_BAR = 4096;
constexpr int CW_HIST = 16384;
constexpr int CW_NP = 20480;
constexpr int CW_PE = 20544;

constexpr int RING_OFF = 0, RING_BYTES = 131072;
constexpr int LDSCTL_OFF = RING_BYTES, MISC_OFF = LDSCTL_OFF + 320;
constexpr int LDS_BYTES = 147456;
static_assert(MISC_OFF + 128 <= LDS_BYTES, "LDS map");
#define GAS __attribute__((address_space(1)))
#define LAS __attribute__((address_space(3)))
typedef unsigned short bf16;
typedef unsigned v4u __attribute__((ext_vector_type(4)));
typedef float f32x4 __attribute__((ext_vector_type(4)));
typedef short bf16x8 __attribute__((ext_vector_type(8)));
typedef GAS unsigned gu32;
typedef GAS unsigned long long gu64;
#define RLX_AGENT __ATOMIC_RELAXED, __HIP_MEMORY_SCOPE_AGENT
#define LDS_WAIT() asm volatile("s_waitcnt lgkmcnt(0)" ::: "memory")
#define VM_WAIT() asm volatile("s_waitcnt vmcnt(0)" ::: "memory")
__device__ __forceinline__ unsigned long long rt() { return __builtin_amdgcn_s_memrealtime(); }
__device__ __forceinline__ unsigned f2bf(float f) { unsigned u = __builtin_bit_cast(unsigned, f); return (u + 0x7fffu + ((u >> 16) & 1u)) >> 16; }
__device__ __forceinline__ unsigned pk2(float lo, float hi) { return f2bf(lo) | (f2bf(hi) << 16); }

#define XB_TMO      128
#define XB_XCNT(j)  (256  + 64 * (j))
#define XB_XSUB(j)  (1280 + 64 * (j))
#define XB_XGEN(j)  (2304 + 64 * (j))
#define XB_TOP      3328
#define XB_TOPGEN   3392
#define XCD_BAR_WORDS 3456
#define XB_SPIN_CAP (1u << 18)

__device__ __forceinline__ unsigned xb_ld(unsigned* p)              { return __hip_atomic_load(p, __ATOMIC_RELAXED, __HIP_MEMORY_SCOPE_AGENT); }
__device__ __forceinline__ unsigned xb_add(unsigned* p, unsigned v) { return __hip_atomic_fetch_add(p, v, __ATOMIC_RELAXED, __HIP_MEMORY_SCOPE_AGENT); }
__device__ __forceinline__ unsigned xb_xcc_id() { return (unsigned)__builtin_amdgcn_s_getreg((3 << 11) | 20) & 0xFu; }
#define XB_SPIN(cond, bar) do { unsigned _sp = 0; while (cond) { __builtin_amdgcn_s_sleep(1); \
    if ((++_sp & 255u) == 0u) { if (xb_ld(&(bar)[XB_TMO])) break; if (_sp > XB_SPIN_CAP) { atomicAdd(&(bar)[XB_TMO], 1u); break; } } } } while (0)

struct XcdBarrier {
    unsigned* bar; unsigned x;
    volatile LAS unsigned* st;
};

__device__ __forceinline__ XcdBarrier xcd_barrier_post(unsigned* bar, volatile LAS unsigned* st) {
    XcdBarrier b; b.bar = bar; b.x = xb_xcc_id(); b.st = st;
    if (threadIdx.x == 0) (void)xb_add(&bar[XB_XCNT(b.x)], 1u);
    return b;
}
__device__ __forceinline__ void xcd_barrier_complete(unsigned* bar, unsigned x, unsigned& nloc, unsigned& nx) {
    const unsigned G = gridDim.x * gridDim.y * gridDim.z;
    unsigned sum, cnt, mine, sp = 0u;
    for (;;) {
        sum = 0u; cnt = 0u; mine = 0u;
#pragma unroll
        for (unsigned j = 0; j < 16; ++j) { const unsigned c = xb_ld(&bar[XB_XCNT(j)]); sum += c; cnt += (c > 0u) ? 1u : 0u; mine = (j == x) ? c : mine; }
        if (sum == G) break;
        __builtin_amdgcn_s_sleep(1);
        if ((++sp & 255u) == 0u) { if (xb_ld(&bar[XB_TMO])) break; if (sp > XB_SPIN_CAP) { atomicAdd(&bar[XB_TMO], 1u); break; } }
    }
    nloc = mine > 0u ? mine : 1u; nx = cnt > 0u ? cnt : 1u;
}

__device__ __forceinline__ void xcd_barrier(const XcdBarrier& b) {
    asm volatile("s_waitcnt vmcnt(0)" ::: "memory");
    __syncthreads();
    if (threadIdx.x == 0) {
        unsigned* bar = b.bar;
        __builtin_amdgcn_s_waitcnt(0);
        unsigned nloc = b.st[0], nx = b.st[1];
        if (nloc == 0u) { xcd_barrier_complete(bar, b.x, nloc, nx); b.st[0] = nloc; b.st[1] = nx; }
        const unsigned old = xb_add(&bar[XB_XSUB(b.x)], 1u);
        const unsigned gen = old / nloc;
        if (old + 1u == (gen + 1u) * nloc) {
            __builtin_amdgcn_fence(__ATOMIC_RELEASE, "agent");
            asm volatile("s_waitcnt vmcnt(0)" ::: "memory");
            const unsigned og = xb_add(&bar[XB_TOP], 1u);
            const unsigned tg = og / nx;
            if (og + 1u == (tg + 1u) * nx) xb_add(&bar[XB_TOPGEN], 1u);
            else XB_SPIN(xb_ld(&bar[XB_TOPGEN]) == tg, bar);
            __builtin_amdgcn_fence(__ATOMIC_ACQUIRE, "agent");
            xb_add(&bar[XB_XGEN(b.x)], 1u);
            asm volatile("s_waitcnt vmcnt(0)" ::: "memory");
        } else {
            XB_SPIN(xb_ld(&bar[XB_XGEN(b.x)]) == gen, bar);
            __builtin_amdgcn_fence(__ATOMIC_ACQUIRE, "agent");
            asm volatile("s_waitcnt vmcnt(0)" ::: "memory");
        }
    }
    __syncthreads();
}
struct Frame {
    LAS unsigned char* lds;
    volatile LAS unsigned* MISC;
    gu32* ctl;
    int tid, lane, wave;
    int vcu, G;
};
struct Args { const float* in[24]; float* out; unsigned char* ws; int ph_lo, ph_hi, pass_lo, pass_hi, sub_lo, sub_hi, li, pad; };

typedef short bf16x4 __attribute__((ext_vector_type(4)));
using pg8::silu_f;
typedef unsigned v2u __attribute__((ext_vector_type(2)));
__device__ __forceinline__ float wave_sum(float v) {
#pragma unroll
    for (int o = 1; o < 64; o <<= 1) v += __shfl_xor(v, o);
    return v;
}
__device__ __forceinline__ float bflo(unsigned u) { return __uint_as_float(u << 16); }
__device__ __forceinline__ float bfhi(unsigned u) { return __uint_as_float(u & 0xffff0000u); }
__device__ __forceinline__ f32x4 mfma16(bf16x8 a, bf16x8 b, f32x4 c) { return __builtin_amdgcn_mfma_f32_16x16x32_bf16(a, b, c, 0, 0, 0); }
__device__ __forceinline__ bf16x8 lds_frag(const LAS unsigned char* p) { return *(const LAS bf16x8*)p; }
__device__ __forceinline__ bf16x8 lds_frag_split(const LAS unsigned char* lo, const LAS unsigned char* hi) {
    const bf16x4 a = *(const LAS bf16x4*)lo, b = *(const LAS bf16x4*)hi; return __builtin_shufflevector(a, b, 0, 1, 2, 3, 4, 5, 6, 7);
}
__device__ __forceinline__ bf16x8 pack_frag(const f32x4& a, const f32x4& b) {
    v4u w; w.x = pk2(a[0], a[1]); w.y = pk2(a[2], a[3]); w.z = pk2(b[0], b[1]); w.w = pk2(b[2], b[3]); return __builtin_bit_cast(bf16x8, w);
}
__device__ __forceinline__ bf16x8 scale_frag(bf16x8 f, float s) {
    const v4u u = __builtin_bit_cast(v4u, f); v4u w;
    w.x = pk2(bflo(u.x) * s, bfhi(u.x) * s); w.y = pk2(bflo(u.y) * s, bfhi(u.y) * s); w.z = pk2(bflo(u.z) * s, bfhi(u.z) * s); w.w = pk2(bflo(u.w) * s, bfhi(u.w) * s);
    return __builtin_bit_cast(bf16x8, w);
}
__device__ __forceinline__ unsigned long long pk4(float a, float b, float c, float d) { return (unsigned long long)pk2(a, b) | ((unsigned long long)pk2(c, d) << 32); }

__device__ __forceinline__ void p0_transpose_item(const float* W, int K, int N, bf16* dst, LAS float* scr, int kb, int nb, int lane) {
    const int k0 = 64 * kb, n0 = 32 * nb;
#pragma unroll 8
    for (int i = 0; i < 32; ++i) { const int kk = 2 * i + (lane >> 5); scr[kk * 33 + (lane & 31)] = W[(size_t)(k0 + kk) * N + n0 + (lane & 31)]; }
    LDS_WAIT(); asm volatile("" ::: "memory");
    const int c = lane & 7;
#pragma unroll
    for (int j = 0; j < 4; ++j) { const int n = (lane >> 3) + 8 * j; const LAS float* s = scr + (8 * c) * 33 + n;
        v4u o; o.x = pk2(s[0 * 33], s[1 * 33]); o.y = pk2(s[2 * 33], s[3 * 33]); o.z = pk2(s[4 * 33], s[5 * 33]); o.w = pk2(s[6 * 33], s[7 * 33]);
        *(GAS v4u*)(dst + (size_t)n * K + k0 + 8 * c) = o; }
    LDS_WAIT(); asm volatile("" ::: "memory");
}
__device__ __forceinline__ void p0_prologue(Frame& F, const Args& A) {
    unsigned char* ws = A.ws;
    LAS float* scr = (LAS float*)(F.lds + RING_OFF + F.wave * 16384);
    const int gw = F.vcu * NWAVES + F.wave, NGW = F.G * NWAVES;
    const int gt = F.vcu * (NWAVES * 64) + F.tid, NGT = F.G * NWAVES * 64;
    constexpr int I_INA = 16 * 56, I_INB = 16 * 80, I_OUT = 16 * 32, I_FF = 16 * 88, I_FFD = 44 * 32, I_EX = 1792;
    constexpr int NSMALL = I_INA + I_INB + 2 * I_OUT + 2 * I_FF + I_FFD, NITEMS = NSMALL + 24 * I_EX;
    for (int it = gw; it < NITEMS; it += NGW) {
        int r = it; const float* src; bf16* dst; int K, N, kind = 0;
        if (r < I_INA) { src = A.in[3]; dst = (bf16*)(ws + WS_WINA); K = DM; N = NINA; }
        else if ((r -= I_INA) < I_INB) { src = A.in[8]; dst = (bf16*)(ws + WS_WINB); K = DM; N = NINB; }
        else if ((r -= I_INB) < 2 * I_OUT) { const int l = r / I_OUT; r -= l * I_OUT; src = A.in[13] + (size_t)l * DM * DM; dst = (bf16*)(ws + WS_WOUT) + (size_t)l * DM * DM; K = DM; N = DM; }
        else if ((r -= 2 * I_OUT) < I_FF) { src = A.in[16]; dst = (bf16*)(ws + WS_WFFGU); K = DM; N = DFF; kind = 1; }
        else if ((r -= I_FF) < I_FF) { src = A.in[17]; dst = (bf16*)(ws + WS_WFFGU); K = DM; N = DFF; kind = 2; }
        else if ((r -= I_FF) < I_FFD) { src = A.in[18]; dst = (bf16*)(ws + WS_WFFD); K = DFF; N = DM; }
        else { r -= I_FFD; const int j = r / I_EX; r -= j * I_EX;
            if (j < 8) { src = A.in[21] + (size_t)j * DM * DFFE; dst = (bf16*)(ws + WS_WEGU) + (size_t)j * 2 * DFFE * DM; K = DM; N = DFFE; kind = 1; }
            else if (j < 16) { src = A.in[22] + (size_t)(j - 8) * DM * DFFE; dst = (bf16*)(ws + WS_WEGU) + (size_t)(j - 8) * 2 * DFFE * DM; K = DM; N = DFFE; kind = 2; }
            else { src = A.in[23] + (size_t)(j - 16) * DFFE * DM; dst = (bf16*)(ws + WS_WED) + (size_t)(j - 16) * DM * DFFE; K = DFFE; N = DM; } }
        const int nblk = N / 32, kb = r / nblk, nb = r % nblk, n0 = 32 * nb;
        const int drow = kind == 0 ? n0 : ((n0 >> 7) * 256 + (n0 & 127) + (kind == 2 ? 128 : 0));
        p0_transpose_item(src, K, N, dst + (size_t)drow * K, scr, kb, nb, F.lane);
    }
    { const float* x = A.in[0]; bf16* XB = (bf16*)(ws + WS_XB);
      for (int m = gw; m < NTOK; m += NGW) { const GAS f32x4* xr = (const GAS f32x4*)(x + (size_t)m * DM) + F.lane; GAS unsigned long long* o8 = (GAS unsigned long long*)(XB + (size_t)m * DM) + F.lane;
#pragma unroll
          for (int j = 0; j < 4; ++j) { const f32x4 v = xr[64 * j]; o8[64 * j] = pk4(v.x, v.y, v.z, v.w); } } }
    { const float* sgw = A.in[6]; bf16* SG = (bf16*)(ws + WS_SGWB);
      for (int i = gt; i < 8 * 128 * 128 / 4; i += NGT) { const f32x4 v = ((const GAS f32x4*)sgw)[i]; ((GAS unsigned long long*)SG)[i] = pk4(v.x, v.y, v.z, v.w); }
      float* rc = (float*)(ws + WS_ROPEC); float* rs = (float*)(ws + WS_ROPES);
      for (int i = gt; i < SEQ * 48; i += NGT) { const int pos = i / 48, k = i - pos * 48;
          const float inv = __builtin_amdgcn_exp2f(-((float)(2 * k) / 96.0f) * 13.287712379549449f);
          const float ang = (float)pos * inv;
          double rev = (double)ang * 0.15915494309189535; rev -= __builtin_rint(rev);
          rc[i] = __builtin_amdgcn_cosf((float)rev); rs[i] = __builtin_amdgcn_sinf((float)rev); }
      int* rowtok = (int*)(ws + WS_ROWTOK);
      for (int i = gt; i < MAX_PANELS * 256; i += NGT) rowtok[i] = 0;
      if (gt < 8) { const float lg = (gt < 4) ? A.in[9][gt] : A.in[10][gt - 4];
          const double ls = -log1p(exp(-(double)lg));
          ((float*)(ws + WS_PRM))[gt] = (float)(ls * 1.4426950408889634); }
    }
    if (F.tid < 128) { const float* mem = A.in[1]; const float* wkv = A.in[2]; bf16* MK = (bf16*)(ws + WS_MEMK); bf16* MVT = (bf16*)(ws + WS_MEMVT);
      for (int item = F.vcu * 128 + F.tid; item < 256 * 128; item += F.G * 128) { const int m0 = (item >> 7) * 4, n0 = (item & 127) * 4;
          f32x4 acc[4];
#pragma unroll
          for (int r = 0; r < 4; ++r) acc[r] = (f32x4){0.f, 0.f, 0.f, 0.f};
          for (int k = 0; k < DM; k += 4) { f32x4 a[4], w[4];
#pragma unroll
              for (int r = 0; r < 4; ++r) a[r] = *(const GAS f32x4*)(mem + (size_t)(m0 + r) * DM + k);
#pragma unroll
              for (int kk = 0; kk < 4; ++kk) w[kk] = *(const GAS f32x4*)(wkv + (size_t)(k + kk) * 512 + n0);
#pragma unroll
              for (int r = 0; r < 4; ++r) { acc[r] += w[0] * a[r].x; acc[r] += w[1] * a[r].y; acc[r] += w[2] * a[r].z; acc[r] += w[3] * a[r].w; } }
#pragma unroll
          for (int r = 0; r < 4; ++r) { const int m = m0 + r;
              if (n0 < 256) { *(GAS unsigned long long*)(MK + (size_t)m * 256 + n0) = pk4(acc[r].x, acc[r].y, acc[r].z, acc[r].w); }
              else { const int hh = (n0 - 256) >> 6, d = (n0 - 256) & 63, b = m >> 8, mm = m & 255; bf16* p = MVT + ((size_t)((b * 4 + hh) * 64 + d)) * 256 + mm;
                  p[0] = (bf16)f2bf(acc[r].x); p[256] = (bf16)f2bf(acc[r].y); p[512] = (bf16)f2bf(acc[r].z); p[768] = (bf16)f2bf(acc[r].w); } } } }
}

__device__ __forceinline__ void attn_unit(Frame& F, const bf16* qb, int ldq, int b, int hh, int t0, const bf16* MK, const bf16* MVT, bf16* CAT, int ocol) {
    LAS unsigned char* QS = F.lds + RING_OFF; LAS unsigned char* KS = QS + 128 * 144; LAS unsigned char* VT = KS + 256 * 144;
    const int tid = F.tid, lane = F.lane, r16 = lane & 15, quad = lane >> 4, w = F.wave;
#pragma unroll
    for (int i = 0; i < 2; ++i) { const int id = tid + 512 * i, row = id >> 3, ch = id & 7;
        *(LAS v4u*)(QS + row * 144 + ch * 16) = *(const GAS v4u*)(qb + (size_t)(t0 + row) * ldq + ch * 8); }
#pragma unroll
    for (int i = 0; i < 4; ++i) { const int id = tid + 512 * i, row = id >> 3, ch = id & 7;
        *(LAS v4u*)(KS + row * 144 + ch * 16) = *(const GAS v4u*)(MK + (size_t)(b * 256 + row) * 256 + hh * 64 + ch * 8); }
#pragma unroll
    for (int i = 0; i < 4; ++i) { const int id = tid + 512 * i, row = id >> 5, ch = id & 31;
        *(LAS v4u*)(VT + row * 528 + ch * 16) = *(const GAS v4u*)(MVT + ((size_t)((b * 4 + hh) * 64 + row)) * 256 + ch * 8); }
    __syncthreads();
    f32x4 s[16];
#pragma unroll
    for (int mt = 0; mt < 16; ++mt) s[mt] = (f32x4){0.f, 0.f, 0.f, 0.f};
#pragma unroll
    for (int ks = 0; ks < 2; ++ks) { const bf16x8 qf = lds_frag(QS + (16 * w + r16) * 144 + ks * 64 + quad * 16);
#pragma unroll
        for (int mt = 0; mt < 16; ++mt) s[mt] = mfma16(lds_frag(KS + (16 * mt + r16) * 144 + ks * 64 + quad * 16), qf, s[mt]); }
    float mx = -3.0e38f;
#pragma unroll
    for (int mt = 0; mt < 16; ++mt) { mx = fmaxf(mx, fmaxf(fmaxf(s[mt][0], s[mt][1]), fmaxf(s[mt][2], s[mt][3]))); }
    mx = fmaxf(mx, __shfl_xor(mx, 16)); mx = fmaxf(mx, __shfl_xor(mx, 32));
    const float c = 0.125f * 1.44269504089f; float sum = 0.f;
#pragma unroll
    for (int mt = 0; mt < 16; ++mt) {
#pragma unroll
        for (int j = 0; j < 4; ++j) { const float e = __builtin_amdgcn_exp2f((s[mt][j] - mx) * c); s[mt][j] = e; sum += e; } }
    sum += __shfl_xor(sum, 16); sum += __shfl_xor(sum, 32);
    const float inv = 1.0f / sum;
    f32x4 o[4];
#pragma unroll
    for (int dt = 0; dt < 4; ++dt) o[dt] = (f32x4){0.f, 0.f, 0.f, 0.f};
#pragma unroll
    for (int st = 0; st < 8; ++st) { const bf16x8 pf = pack_frag(s[2 * st] * inv, s[2 * st + 1] * inv);
#pragma unroll
        for (int dt = 0; dt < 4; ++dt) { const LAS unsigned char* vp = VT + (16 * dt + r16) * 528 + (32 * st + 4 * quad) * 2;
            o[dt] = mfma16(lds_frag_split(vp, vp + 32), pf, o[dt]); } }
    bf16* op = CAT + (size_t)(t0 + 16 * w + r16) * DM + ocol + 4 * quad;
#pragma unroll
    for (int dt = 0; dt < 4; ++dt) *(GAS unsigned long long*)(op + 16 * dt) = pk4(o[dt][0], o[dt][1], o[dt][2], o[dt][3]);
    __syncthreads();
}

__device__ __forceinline__ void mixer_a_unit(Frame& F, const Args& A, int unit) {
    unsigned char* ws = A.ws;
    const bf16* H0 = (const bf16*)(ws + WS_H0); bf16* CAT = (bf16*)(ws + WS_CAT0); const bf16* SG = (const bf16*)(ws + WS_SGWB);
    const float* lng = A.in[4]; const float* lnb = A.in[5]; const float* sgb = A.in[7];
    const int t0 = unit * 128, tid = F.tid, lane = F.lane, r16 = lane & 15, quad = lane >> 4, w = F.wave;
    LAS float* STAT = (LAS float*)(F.lds + RING_OFF);
    LAS unsigned char* WS_ = F.lds + RING_OFF + 1024;
    LAS unsigned char* VT = WS_ + 128 * 272;
    for (int rr = 0; rr < 16; ++rr) { const int row = 16 * w + rr; const bf16* vp = H0 + (size_t)(t0 + row) * NINA + MIXW + 4 * lane;
        float x[12];
#pragma unroll
        for (int j = 0; j < 3; ++j) { const v2u r = *(const GAS v2u*)(vp + 256 * j); x[4 * j] = bflo(r.x); x[4 * j + 1] = bfhi(r.x); x[4 * j + 2] = bflo(r.y); x[4 * j + 3] = bfhi(r.y); }
        float sm = 0.f;
#pragma unroll
        for (int j = 0; j < 12; ++j) sm += x[j];
        const float mean = wave_sum(sm) * (1.0f / 768.0f); float q = 0.f;
#pragma unroll
        for (int j = 0; j < 12; ++j) { const float d = x[j] - mean; q += d * d; }
        const float rstd = 1.0f / sqrtf(wave_sum(q) * (1.0f / 768.0f) + LN_EPS);
        if (lane == 0) { STAT[2 * row] = mean; STAT[2 * row + 1] = rstd; } }
    __syncthreads();
    for (int g = 0; g < 8; ++g) {
#pragma unroll
        for (int i = 0; i < 4; ++i) { const int id = tid + 512 * i, p = id >> 4, ch = id & 15;
            *(LAS v4u*)(WS_ + p * 272 + ch * 16) = *(const GAS v4u*)(SG + (size_t)g * 16384 + p * 128 + ch * 8); }
#pragma unroll
        for (int i = 0; i < 3; ++i) { const int id = tid + 512 * i, q = id & 127, cc = id >> 7; const int c0 = g * 96 + cc * 8;
            const v4u r = *(const GAS v4u*)(H0 + (size_t)(t0 + q) * NINA + MIXW + c0);
            const float mean = STAT[2 * q], rstd = STAT[2 * q + 1];
            const f32x4 g0 = *(const GAS f32x4*)(lng + c0), g1 = *(const GAS f32x4*)(lng + c0 + 4), b0 = *(const GAS f32x4*)(lnb + c0), b1 = *(const GAS f32x4*)(lnb + c0 + 4);
            LAS unsigned short* vt = (LAS unsigned short*)(VT + (cc * 8) * 272 + q * 2);
            vt[0 * 136] = (unsigned short)f2bf((bflo(r.x) - mean) * rstd * g0.x + b0.x); vt[1 * 136] = (unsigned short)f2bf((bfhi(r.x) - mean) * rstd * g0.y + b0.y);
            vt[2 * 136] = (unsigned short)f2bf((bflo(r.y) - mean) * rstd * g0.z + b0.z); vt[3 * 136] = (unsigned short)f2bf((bfhi(r.y) - mean) * rstd * g0.w + b0.w);
            vt[4 * 136] = (unsigned short)f2bf((bflo(r.z) - mean) * rstd * g1.x + b1.x); vt[5 * 136] = (unsigned short)f2bf((bfhi(r.z) - mean) * rstd * g1.y + b1.y);
            vt[6 * 136] = (unsigned short)f2bf((bflo(r.w) - mean) * rstd * g1.z + b1.z); vt[7 * 136] = (unsigned short)f2bf((bfhi(r.w) - mean) * rstd * g1.w + b1.w); }
        __syncthreads();
        f32x4 acc[6];
#pragma unroll
        for (int ct = 0; ct < 6; ++ct) acc[ct] = (f32x4){0.f, 0.f, 0.f, 0.f};
#pragma unroll
        for (int ks = 0; ks < 4; ++ks) { const bf16x8 wf = lds_frag(WS_ + (16 * w + r16) * 272 + ks * 64 + quad * 16);
#pragma unroll
            for (int ct = 0; ct < 6; ++ct) acc[ct] = mfma16(lds_frag(VT + (16 * ct + r16) * 272 + ks * 64 + quad * 16), wf, acc[ct]); }
        const int p = 16 * w + r16; const float bias = sgb[g * 128 + p];
        const bf16* up = H0 + (size_t)(t0 + p) * NINA + g * 96 + 4 * quad; bf16* op = CAT + (size_t)(t0 + p) * DM + g * 96 + 4 * quad;
#pragma unroll
        for (int ct = 0; ct < 6; ++ct) { const v2u u = *(const GAS v2u*)(up + 16 * ct);
            *(GAS unsigned long long*)(op + 16 * ct) = pk4(bflo(u.x) * (acc[ct][0] + bias), bfhi(u.x) * (acc[ct][1] + bias), bflo(u.y) * (acc[ct][2] + bias), bfhi(u.y) * (acc[ct][3] + bias)); }
        __syncthreads();
    }
    const int b = t0 / SEQ;
    for (int hh = 0; hh < 4; ++hh) attn_unit(F, H0 + 2 * MIXW + hh * 64, NINA, b, hh, t0, (const bf16*)(ws + WS_MEMK), (const bf16*)(ws + WS_MEMVT), CAT, MIXW + hh * 64);
}

__device__ __forceinline__ void ln_rows(Frame& F, const float* Z, const float* g, const float* b, bf16* X) {
    const int gw = F.vcu * NWAVES + F.wave, NGW = F.G * NWAVES;
    f32x4 gv[4], bv[4];
#pragma unroll
    for (int j = 0; j < 4; ++j) { gv[j] = ((const GAS f32x4*)g)[F.lane + 64 * j]; bv[j] = ((const GAS f32x4*)b)[F.lane + 64 * j]; }
    for (int m = gw; m < NTOK; m += NGW) { const GAS f32x4* zr = (const GAS f32x4*)(Z + (size_t)m * DM) + F.lane;
        f32x4 v[4]; float s = 0.f;
#pragma unroll
        for (int j = 0; j < 4; ++j) { v[j] = zr[64 * j]; s += (v[j].x + v[j].y) + (v[j].z + v[j].w); }
        const float mean = wave_sum(s) * (1.f / DM); float s2 = 0.f;
#pragma unroll
        for (int j = 0; j < 4; ++j) { v[j] = v[j] - mean; s2 += (v[j].x * v[j].x + v[j].y * v[j].y) + (v[j].z * v[j].z + v[j].w * v[j].w); }
        const float rstd = 1.f / sqrtf(wave_sum(s2) * (1.f / DM) + LN_EPS);
        GAS unsigned long long* o8 = (GAS unsigned long long*)(X + (size_t)m * DM) + F.lane;
#pragma unroll
        for (int j = 0; j < 4; ++j) { const f32x4 y = v[j] * rstd * gv[j] + bv[j]; o8[64 * j] = pk4(y.x, y.y, y.z, y.w); } }
}

__device__ __forceinline__ void ret_kv_unit(Frame& F, const Args& A, int unit) {
    unsigned char* ws = A.ws;
    const bf16* H1 = (const bf16*)(ws + WS_H1); bf16* KVS = (bf16*)A.out; const float* rc = (const float*)(ws + WS_ROPEC); const float* rs = (const float*)(ws + WS_ROPES); const float* prm = (const float*)(ws + WS_PRM);
    const int h = unit & 3, bn = unit >> 2, n = bn & 63, t0 = bn * 128, tid = F.tid, lane = F.lane, r16 = lane & 15, quad = lane >> 4, w = F.wave;
    const float l2f = prm[h], l2b = prm[4 + h];
    LAS unsigned char* KF = F.lds + RING_OFF; LAS unsigned char* KB = KF + 96 * 272; LAS unsigned char* VT = KB + 96 * 272;
#pragma unroll
    for (int i = 0; i < 2; ++i) { const int id = tid + 512 * i; if (id < 768) { const int j = id & 127, gq = id >> 7;
        const bf16* kp = H1 + (size_t)(t0 + j) * NINB + QKW + h * 96 + gq * 8; const v4u r1 = *(const GAS v4u*)kp, r2 = *(const GAS v4u*)(kp + 48);
        const int pos = n * 128 + j; const float* cp = rc + pos * 48 + gq * 8; const float* sp = rs + pos * 48 + gq * 8;
        const f32x4 c0 = *(const GAS f32x4*)cp, c1 = *(const GAS f32x4*)(cp + 4), s0 = *(const GAS f32x4*)sp, s1 = *(const GAS f32x4*)(sp + 4);
        const float sf = __builtin_amdgcn_exp2f((float)(128 - j) * l2f), sb = __builtin_amdgcn_exp2f((float)(j + 1) * l2b);
        const float t1[8] = {bflo(r1.x), bfhi(r1.x), bflo(r1.y), bfhi(r1.y), bflo(r1.z), bfhi(r1.z), bflo(r1.w), bfhi(r1.w)};
        const float t2[8] = {bflo(r2.x), bfhi(r2.x), bflo(r2.y), bfhi(r2.y), bflo(r2.z), bfhi(r2.z), bflo(r2.w), bfhi(r2.w)};
        const float cc[8] = {c0.x, c0.y, c0.z, c0.w, c1.x, c1.y, c1.z, c1.w}, ss[8] = {s0.x, s0.y, s0.z, s0.w, s1.x, s1.y, s1.z, s1.w};
        LAS unsigned short* kf = (LAS unsigned short*)(KF + (gq * 8) * 272 + j * 2); LAS unsigned short* kb = (LAS unsigned short*)(KB + (gq * 8) * 272 + j * 2);
#pragma unroll
        for (int e = 0; e < 8; ++e) { const float o1 = t1[e] * cc[e] - t2[e] * ss[e], o2 = t2[e] * cc[e] + t1[e] * ss[e];
            kf[e * 136] = (unsigned short)f2bf(o1 * sf); kf[(48 + e) * 136] = (unsigned short)f2bf(o2 * sf);
            kb[e * 136] = (unsigned short)f2bf(o1 * sb); kb[(48 + e) * 136] = (unsigned short)f2bf(o2 * sb); } } }
#pragma unroll
    for (int i = 0; i < 6; ++i) { const int id = tid + 512 * i, j = id & 127, ec = id >> 7;
        const v4u r = *(const GAS v4u*)(H1 + (size_t)(t0 + j) * NINB + 2 * QKW + h * 192 + ec * 8);
        LAS unsigned short* vt = (LAS unsigned short*)(VT + (ec * 8) * 272 + j * 2);
        vt[0 * 136] = (unsigned short)(r.x & 0xffffu); vt[1 * 136] = (unsigned short)(r.x >> 16); vt[2 * 136] = (unsigned short)(r.y & 0xffffu); vt[3 * 136] = (unsigned short)(r.y >> 16);
        vt[4 * 136] = (unsigned short)(r.z & 0xffffu); vt[5 * 136] = (unsigned short)(r.z >> 16); vt[6 * 136] = (unsigned short)(r.w & 0xffffu); vt[7 * 136] = (unsigned short)(r.w >> 16); }
    __syncthreads();
    const int dir = w & 1, eg = w >> 1; const LAS unsigned char* KX = dir ? KB : KF;
    f32x4 acc[3][6];
#pragma unroll
    for (int et = 0; et < 3; ++et)
#pragma unroll
        for (int dt = 0; dt < 6; ++dt) acc[et][dt] = (f32x4){0.f, 0.f, 0.f, 0.f};
#pragma unroll
    for (int ks = 0; ks < 4; ++ks) { bf16x8 kf[6];
#pragma unroll
        for (int dt = 0; dt < 6; ++dt) kf[dt] = lds_frag(KX + (16 * dt + r16) * 272 + ks * 64 + quad * 16);
#pragma unroll
        for (int et = 0; et < 3; ++et) { const bf16x8 vf = lds_frag(VT + (16 * (3 * eg + et) + r16) * 272 + ks * 64 + quad * 16);
#pragma unroll
            for (int dt = 0; dt < 6; ++dt) acc[et][dt] = mfma16(kf[dt], vf, acc[et][dt]); } }
    bf16* out = KVS + ((size_t)unit * 2 + dir) * (192 * 96);
#pragma unroll
    for (int et = 0; et < 3; ++et) { const int e = 16 * (3 * eg + et) + r16;
#pragma unroll
        for (int dt = 0; dt < 6; ++dt) *(GAS unsigned long long*)(out + (size_t)e * 96 + 16 * dt + 4 * quad) = pk4(acc[et][dt][0], acc[et][dt][1], acc[et][dt][2], acc[et][dt][3]); }
    __syncthreads();
}

__device__ __forceinline__ void ret_scan(Frame& F, const Args& A) {
    bf16* KVS = (bf16*)A.out; const float* prm = (const float*)(A.ws + WS_PRM);
    const int gt = F.vcu * (NWAVES * 64) + F.tid, NGT = F.G * NWAVES * 64;
    for (int idx = gt; idx < 32 * 2304; idx += NGT) { const int combo = idx / 2304, v = idx - combo * 2304, b = combo >> 3, h = (combo >> 1) & 3, dir = combo & 1;
        const float decay = __builtin_amdgcn_exp2f(128.0f * prm[dir * 4 + h]);
        float S[8];
#pragma unroll
        for (int j = 0; j < 8; ++j) S[j] = 0.f;
        for (int step = 0; step < 64; step += 4) { v4u r[4]; GAS v4u* p[4];
#pragma unroll
            for (int u = 0; u < 4; ++u) { const int n = dir ? 63 - (step + u) : (step + u);
                p[u] = (GAS v4u*)(KVS + ((size_t)(((b * 64 + n) * 4 + h) * 2 + dir)) * (192 * 96) + (size_t)v * 8); r[u] = *p[u]; }
#pragma unroll
            for (int u = 0; u < 4; ++u) { const float t[8] = {bflo(r[u].x), bfhi(r[u].x), bflo(r[u].y), bfhi(r[u].y), bflo(r[u].z), bfhi(r[u].z), bflo(r[u].w), bfhi(r[u].w)};
                v4u o; o.x = pk2(S[0], S[1]); o.y = pk2(S[2], S[3]); o.z = pk2(S[4], S[5]); o.w = pk2(S[6], S[7]); *p[u] = o;
#pragma unroll
                for (int j = 0; j < 8; ++j) S[j] = S[j] * decay + t[j]; } } }
}

__device__ __forceinline__ void ret_out_unit(Frame& F, const Args& A, int unit) {
    unsigned char* ws = A.ws;
    const bf16* H1 = (const bf16*)(ws + WS_H1); const bf16* KVS = (const bf16*)A.out; bf16* CAT = (bf16*)(ws + WS_CAT1);
    const float* rc = (const float*)(ws + WS_ROPEC); const float* rs = (const float*)(ws + WS_ROPES); const float* prm = (const float*)(ws + WS_PRM);
    const float* gng = A.in[11]; const float* gnb = A.in[12];
    const int h = unit & 3, bn = unit >> 2, n = bn & 63, t0 = bn * 128, tid = F.tid, lane = F.lane, r16 = lane & 15, quad = lane >> 4, w = F.wave;
    const float l2f = prm[h], l2b = prm[4 + h];
    LAS unsigned char* QS = F.lds + RING_OFF; LAS unsigned char* VT = QS + 128 * 208; LAS unsigned char* XS = VT + 192 * 272;
#pragma unroll
    for (int i = 0; i < 3; ++i) { const int id = tid + 512 * i, isk = id >= 768, id2 = isk ? id - 768 : id, row = id2 / 6, gq = id2 - row * 6;
        const bf16* qp = H1 + (size_t)(t0 + row) * NINB + (isk ? QKW : 0) + h * 96 + gq * 8; const v4u r1 = *(const GAS v4u*)qp, r2 = *(const GAS v4u*)(qp + 48);
        const int pos = n * 128 + row; const float* cp = rc + pos * 48 + gq * 8; const float* sp = rs + pos * 48 + gq * 8;
        const f32x4 c0 = *(const GAS f32x4*)cp, c1 = *(const GAS f32x4*)(cp + 4), s0 = *(const GAS f32x4*)sp, s1 = *(const GAS f32x4*)(sp + 4);
        const float sc = isk ? 1.0f : 0.10206207261596577f;
        const float t1[8] = {bflo(r1.x), bfhi(r1.x), bflo(r1.y), bfhi(r1.y), bflo(r1.z), bfhi(r1.z), bflo(r1.w), bfhi(r1.w)};
        const float t2[8] = {bflo(r2.x), bfhi(r2.x), bflo(r2.y), bfhi(r2.y), bflo(r2.z), bfhi(r2.z), bflo(r2.w), bfhi(r2.w)};
        const float cc[8] = {c0.x, c0.y, c0.z, c0.w, c1.x, c1.y, c1.z, c1.w}, ss[8] = {s0.x, s0.y, s0.z, s0.w, s1.x, s1.y, s1.z, s1.w};
        float o1[8], o2[8];
#pragma unroll
        for (int e = 0; e < 8; ++e) { o1[e] = (t1[e] * cc[e] - t2[e] * ss[e]) * sc; o2[e] = (t2[e] * cc[e] + t1[e] * ss[e]) * sc; }
        LAS unsigned char* dst = (isk ? XS : QS) + row * 208 + gq * 16;
        v4u w1, w2; w1.x = pk2(o1[0], o1[1]); w1.y = pk2(o1[2], o1[3]); w1.z = pk2(o1[4], o1[5]); w1.w = pk2(o1[6], o1[7]); w2.x = pk2(o2[0], o2[1]); w2.y = pk2(o2[2], o2[3]); w2.z = pk2(o2[4], o2[5]); w2.w = pk2(o2[6], o2[7]);
        *(LAS v4u*)dst = w1; *(LAS v4u*)(dst + 96) = w2; }
#pragma unroll
    for (int i = 0; i < 6; ++i) { const int id = tid + 512 * i, j = id & 127, ec = id >> 7;
        const v4u r = *(const GAS v4u*)(H1 + (size_t)(t0 + j) * NINB + 2 * QKW + h * 192 + ec * 8);
        LAS unsigned short* vt = (LAS unsigned short*)(VT + (ec * 8) * 272 + j * 2);
        vt[0 * 136] = (unsigned short)(r.x & 0xffffu); vt[1 * 136] = (unsigned short)(r.x >> 16); vt[2 * 136] = (unsigned short)(r.y & 0xffffu); vt[3 * 136] = (unsigned short)(r.y >> 16);
        vt[4 * 136] = (unsigned short)(r.z & 0xffffu); vt[5 * 136] = (unsigned short)(r.z >> 16); vt[6 * 136] = (unsigned short)(r.w & 0xffffu); vt[7 * 136] = (unsigned short)(r.w >> 16); }
    __syncthreads();
    const int ii = 16 * w + r16;
    bf16x8 qf[3], pf[4];
    { f32x4 s[8];
#pragma unroll
      for (int jt = 0; jt < 8; ++jt) s[jt] = (f32x4){0.f, 0.f, 0.f, 0.f};
#pragma unroll
      for (int ks = 0; ks < 3; ++ks) { qf[ks] = lds_frag(QS + ii * 208 + ks * 64 + quad * 16);
#pragma unroll
          for (int jt = 0; jt < 8; ++jt) s[jt] = mfma16(lds_frag(XS + (16 * jt + r16) * 208 + ks * 64 + quad * 16), qf[ks], s[jt]); }
#pragma unroll
      for (int jt = 0; jt < 8; ++jt)
#pragma unroll
          for (int r = 0; r < 4; ++r) { const int df = ii - (16 * jt + 4 * quad + r); const float m = df >= 0 ? __builtin_amdgcn_exp2f((float)df * l2f) : __builtin_amdgcn_exp2f((float)(-df) * l2b); s[jt][r] *= m; }
#pragma unroll
      for (int st = 0; st < 4; ++st) pf[st] = pack_frag(s[2 * st], s[2 * st + 1]); }
    __syncthreads();
    const bf16* SF = KVS + ((size_t)unit * 2 + 0) * (192 * 96); const bf16* SB = KVS + ((size_t)unit * 2 + 1) * (192 * 96);
#pragma unroll
    for (int i = 0; i < 5; ++i) { const int id = tid + 512 * i; if (id < 2304) { const int e = id / 12, ch = id - e * 12; *(LAS v4u*)(XS + e * 208 + ch * 16) = *(const GAS v4u*)(SF + (size_t)e * 96 + ch * 8); } }
    f32x4 o[12];
#pragma unroll
    for (int et = 0; et < 12; ++et) o[et] = (f32x4){0.f, 0.f, 0.f, 0.f};
#pragma unroll
    for (int st = 0; st < 4; ++st)
#pragma unroll
        for (int et = 0; et < 12; ++et) { const LAS unsigned char* vp = VT + (16 * et + r16) * 272 + (32 * st + 4 * quad) * 2; o[et] = mfma16(lds_frag_split(vp, vp + 32), pf[st], o[et]); }
    __syncthreads();
    { const float sc = __builtin_amdgcn_exp2f((float)ii * l2f);
#pragma unroll
      for (int ks = 0; ks < 3; ++ks) { const bf16x8 q2 = scale_frag(qf[ks], sc);
#pragma unroll
          for (int et = 0; et < 12; ++et) o[et] = mfma16(lds_frag(XS + (16 * et + r16) * 208 + ks * 64 + quad * 16), q2, o[et]); } }
    __syncthreads();
#pragma unroll
    for (int i = 0; i < 5; ++i) { const int id = tid + 512 * i; if (id < 2304) { const int e = id / 12, ch = id - e * 12; *(LAS v4u*)(XS + e * 208 + ch * 16) = *(const GAS v4u*)(SB + (size_t)e * 96 + ch * 8); } }
    __syncthreads();
    { const float sc = __builtin_amdgcn_exp2f((float)(127 - ii) * l2b);
#pragma unroll
      for (int ks = 0; ks < 3; ++ks) { const bf16x8 q2 = scale_frag(qf[ks], sc);
#pragma unroll
          for (int et = 0; et < 12; ++et) o[et] = mfma16(lds_frag(XS + (16 * et + r16) * 208 + ks * 64 + quad * 16), q2, o[et]); } }
    float sm = 0.f;
#pragma unroll
    for (int et = 0; et < 12; ++et) sm += (o[et][0] + o[et][1]) + (o[et][2] + o[et][3]);
    sm += __shfl_xor(sm, 16); sm += __shfl_xor(sm, 32);
    const float mean = sm * (1.0f / 192.0f); float q = 0.f;
#pragma unroll
    for (int et = 0; et < 12; ++et) { o[et] = o[et] - mean; q += (o[et][0] * o[et][0] + o[et][1] * o[et][1]) + (o[et][2] * o[et][2] + o[et][3] * o[et][3]); }
    q += __shfl_xor(q, 16); q += __shfl_xor(q, 32);
    const float rstd = 1.0f / sqrtf(q * (1.0f / 192.0f) + LN_EPS);
    const int col = h * 192 + 4 * quad; const bf16* gp = H1 + (size_t)(t0 + ii) * NINB + 2 * QKW + MIXW + col; bf16* op = CAT + (size_t)(t0 + ii) * DM + col;
#pragma unroll
    for (int et = 0; et < 12; ++et) { const v2u gr = *(const GAS v2u*)(gp + 16 * et); const f32x4 gg = *(const GAS f32x4*)(gng + col + 16 * et), gb = *(const GAS f32x4*)(gnb + col + 16 * et);
        const f32x4 y = o[et] * rstd * gg + gb;
        *(GAS unsigned long long*)(op + 16 * et) = pk4(silu_f(bflo(gr.x)) * y[0], silu_f(bfhi(gr.x)) * y[1], silu_f(bflo(gr.y)) * y[2], silu_f(bfhi(gr.y)) * y[3]); }
    __syncthreads();
    attn_unit(F, H1 + 2 * QKW + 2 * MIXW + h * 64, NINB, t0 / SEQ, h, t0, (const bf16*)(ws + WS_MEMK), (const bf16*)(ws + WS_MEMVT), CAT, MIXW + h * 64);
}

__device__ __forceinline__ void ln_router(Frame& F, const Args& A, const float* Z, const float* g, const float* b, bf16* X) {
    const int gw = F.vcu * NWAVES + F.wave, NGW = F.G * NWAVES;
    const float* wr = A.in[19]; const float* br = A.in[20];
    LAS float* WT = (LAS float*)(F.lds + RING_OFF);
    for (int i = F.tid; i < 8192; i += NWAVES * 64) WT[(i & 7) * 1024 + (i >> 3)] = wr[i];
    __syncthreads();
    int* topi = (int*)(A.ws + WS_TOPI); float* gate = (float*)(A.ws + WS_GATE); unsigned* hist = (unsigned*)(F.ctl + CW_HIST);
    f32x4 gv[4], bv[4];
#pragma unroll
    for (int j = 0; j < 4; ++j) { gv[j] = ((const GAS f32x4*)g)[F.lane + 64 * j]; bv[j] = ((const GAS f32x4*)b)[F.lane + 64 * j]; }
    for (int m = gw; m < NTOK; m += NGW) { const GAS f32x4* zr = (const GAS f32x4*)(Z + (size_t)m * DM) + F.lane;
        f32x4 v[4]; float s = 0.f;
#pragma unroll
        for (int j = 0; j < 4; ++j) { v[j] = zr[64 * j]; s += (v[j].x + v[j].y) + (v[j].z + v[j].w); }
        const float mean = wave_sum(s) * (1.f / DM); float s2 = 0.f;
#pragma unroll
        for (int j = 0; j < 4; ++j) { v[j] = v[j] - mean; s2 += (v[j].x * v[j].x + v[j].y * v[j].y) + (v[j].z * v[j].z + v[j].w * v[j].w); }
        const float rstd = 1.f / sqrtf(wave_sum(s2) * (1.f / DM) + LN_EPS);
        GAS unsigned long long* o8 = (GAS unsigned long long*)(X + (size_t)m * DM) + F.lane;
#pragma unroll
        for (int j = 0; j < 4; ++j) { v[j] = v[j] * rstd * gv[j] + bv[j]; o8[64 * j] = pk4(v[j].x, v[j].y, v[j].z, v[j].w); }
        float lg[8];
#pragma unroll
        for (int e = 0; e < 8; ++e) { float p = 0.f;
#pragma unroll
            for (int j = 0; j < 4; ++j) { const f32x4 wv = *(const LAS f32x4*)(WT + e * 1024 + 4 * F.lane + 256 * j); p += (v[j].x * wv.x + v[j].y * wv.y) + (v[j].z * wv.z + v[j].w * wv.w); }
            lg[e] = wave_sum(p) + br[e]; }
        int e0 = 0; float l0 = lg[0];
#pragma unroll
        for (int e = 1; e < 8; ++e) if (lg[e] > l0) { l0 = lg[e]; e0 = e; }
        int e1 = -1; float l1 = -3.0e38f;
#pragma unroll
        for (int e = 0; e < 8; ++e) if (e != e0 && lg[e] > l1) { l1 = lg[e]; e1 = e; }
        if (F.lane == 0) { const float w0 = 1.0f / (1.0f + __builtin_amdgcn_exp2f((l1 - l0) * 1.44269504089f));
            topi[2 * m] = e0; topi[2 * m + 1] = e1; gate[2 * m] = w0; gate[2 * m + 1] = 1.0f - w0;
            atomicAdd(hist + (m >> 7) * 8 + e0, 1u); atomicAdd(hist + (m >> 7) * 8 + e1, 1u); } }
    __syncthreads();
}

__device__ __forceinline__ void route_positions(Frame& F, const Args& A) {
    LAS int* bh = (LAS int*)(F.lds + RING_OFF); LAS int* pre = bh + 2048; LAS int* cnt = pre + 2048;
    const unsigned* hist = (const unsigned*)(F.ctl + CW_HIST);
    for (int i = F.tid; i < 2048; i += NWAVES * 64) bh[i] = (int)hist[i];
    __syncthreads();
    if (F.tid < 8) { int run = 0; for (int blk = 0; blk < 256; ++blk) { pre[blk * 8 + F.tid] = run; run += bh[blk * 8 + F.tid]; } cnt[F.tid] = run; }
    __syncthreads();
    if (F.tid == 0) { int ps = 0; for (int e = 0; e < 8; ++e) { cnt[8 + e] = ps; ps += ((cnt[e] + 255) >> 8) << 8; } cnt[16] = ps >> 8; }
    __syncthreads();
    if (F.vcu == 0) { int* pe = (int*)(F.ctl + CW_PE);
        for (int p = F.tid; p < 272; p += NWAVES * 64) { const int row = p * 256; int e = 0;
#pragma unroll
            for (int ee = 1; ee < 8; ++ee) if (row >= cnt[8 + ee]) e = ee;
            pe[p] = e; }
        if (F.tid == 0) *(int*)(F.ctl + CW_NP) = cnt[16]; }
    const int* topi = (const int*)(A.ws + WS_TOPI); int* dest = (int*)(A.ws + WS_DEST); int* rowtok = (int*)(A.ws + WS_ROWTOK);
    if (F.wave == 0) for (int blk = F.vcu; blk < 256; blk += F.G) { int run[8];
#pragma unroll
        for (int e = 0; e < 8; ++e) run[e] = 0;
        const unsigned long long lt = (1ull << F.lane) - 1ull;
        for (int ps = 0; ps < 4; ++ps) { const int a = blk * 256 + ps * 64 + F.lane; const int e = topi[a]; int rank = 0;
#pragma unroll
            for (int ee = 0; ee < 8; ++ee) { const unsigned long long mk = __ballot(e == ee); if (e == ee) rank = run[ee] + __popcll(mk & lt); run[ee] += __popcll(mk); }
            const int d = cnt[8 + e] + pre[blk * 8 + e] + rank; dest[a] = d; rowtok[d] = a >> 1; } }
    __syncthreads();
}

__device__ __forceinline__ void final_rows(Frame& F, const Args& A) {
    const int gw = F.vcu * NWAVES + F.wave, NGW = F.G * NWAVES;
    const bf16* X3 = (const bf16*)(A.ws + WS_X3); const bf16* YR = (const bf16*)(A.ws + WS_YR); const int* dest = (const int*)(A.ws + WS_DEST); const float* gate = (const float*)(A.ws + WS_GATE);
    const float* g = A.in[14] + 3 * DM; const float* b = A.in[15] + 3 * DM; float* out = A.out;
    f32x4 gv[4], bv[4];
#pragma unroll
    for (int j = 0; j < 4; ++j) { gv[j] = ((const GAS f32x4*)g)[F.lane + 64 * j]; bv[j] = ((const GAS f32x4*)b)[F.lane + 64 * j]; }
    for (int m = gw; m < NTOK; m += NGW) { const int d0 = dest[2 * m], d1 = dest[2 * m + 1]; const float w0 = gate[2 * m], w1 = gate[2 * m + 1];
        const GAS v2u* xr = (const GAS v2u*)(X3 + (size_t)m * DM) + F.lane; const GAS v2u* y0 = (const GAS v2u*)(YR + (size_t)d0 * DM) + F.lane; const GAS v2u* y1 = (const GAS v2u*)(YR + (size_t)d1 * DM) + F.lane;
        f32x4 v[4]; float s = 0.f;
#pragma unroll
        for (int j = 0; j < 4; ++j) { const v2u a = xr[64 * j], p = y0[64 * j], q = y1[64 * j];
            v[j].x = ALPHA * bflo(a.x) + (w0 * bflo(p.x) + w1 * bflo(q.x)); v[j].y = ALPHA * bfhi(a.x) + (w0 * bfhi(p.x) + w1 * bfhi(q.x));
            v[j].z = ALPHA * bflo(a.y) + (w0 * bflo(p.y) + w1 * bflo(q.y)); v[j].w = ALPHA * bfhi(a.y) + (w0 * bfhi(p.y) + w1 * bfhi(q.y));
            s += (v[j].x + v[j].y) + (v[j].z + v[j].w); }
        const float mean = wave_sum(s) * (1.f / DM); float s2 = 0.f;
#pragma unroll
        for (int j = 0; j < 4; ++j) { v[j] = v[j] - mean; s2 += (v[j].x * v[j].x + v[j].y * v[j].y) + (v[j].z * v[j].z + v[j].w * v[j].w); }
        const float rstd = 1.f / sqrtf(wave_sum(s2) * (1.f / DM) + LN_EPS);
        GAS f32x4* o = (GAS f32x4*)(out + (size_t)m * DM) + F.lane;
#pragma unroll
        for (int j = 0; j < 4; ++j) o[64 * j] = v[j] * rstd * gv[j] + bv[j]; }
}
constexpr int N_PHASES = 17;
__global__ void __launch_bounds__(NWAVES * 64, 2) hyb_fwd(Args args) {
    extern __shared__ __attribute__((aligned(16))) unsigned char lds[];
    Frame F;
    F.lds = (LAS unsigned char*)lds;
    F.MISC = (volatile LAS unsigned*)(F.lds + MISC_OFF);
    F.tid = threadIdx.x; F.lane = F.tid & 63; F.wave = __builtin_amdgcn_readfirstlane(F.tid >> 6);
    F.G = gridDim.x; { const int bx = blockIdx.x; F.vcu = (F.G % 8 == 0) ? (bx % 8) * (F.G / 8) + bx / 8 : bx; }
    unsigned char* ws = args.ws;
    F.ctl = (gu32*)(ws + WS_CTL);
    for (int u = F.tid; u < (LDS_BYTES - LDSCTL_OFF) / 4; u += NWAVES * 64) ((LAS unsigned*)(F.lds + LDSCTL_OFF))[u] = 0u;
    __syncthreads();
    XcdBarrier bar; bar.bar = (unsigned*)(F.ctl + CW_BAR); bar.x = 0; bar.st = nullptr;
    if (MK_SINGLE) bar = xcd_barrier_post((unsigned*)(F.ctl + CW_BAR), F.MISC + 8);
#define GRID_BAR() do { if (MK_SINGLE) xcd_barrier(bar); } while (0)
    const int lo = args.ph_lo, hi = args.ph_hi;
#define IN(k) (lo <= (k) && (k) < hi)
#define BOTH(k) (IN(k) && IN((k) + 1))
    bf16* const XB = (bf16*)(ws + WS_XB); bf16* const H0 = (bf16*)(ws + WS_H0); bf16* const CAT0 = (bf16*)(ws + WS_CAT0); bf16* const X1 = (bf16*)(ws + WS_X1);
    bf16* const HID = (bf16*)(ws + WS_HID); bf16* const X2 = (bf16*)(ws + WS_X2); bf16* const H1 = (bf16*)(ws + WS_H1); bf16* const CAT1 = (bf16*)(ws + WS_CAT1);
    bf16* const X3 = (bf16*)(ws + WS_X3); bf16* const XG = (bf16*)(ws + WS_XG); bf16* const YR = (bf16*)(ws + WS_YR); bf16* const HIDE = (bf16*)args.out;
    float* const Z = args.out;

    if (IN(0)) { p0_prologue(F, args); if (BOTH(0)) GRID_BAR(); }
    if (IN(1)) { pg8::Gemm g{XB, (const bf16*)(ws + WS_WINA), NTOK, NINA, DM}; pg8::StaticOrder S; S.init(NTOK, NINA, F.G, (int)blockIdx.x);
        pg8::EpiAct E{H0, NINA, 6, 0};
        pg8::gemm_phase<pg8::EpiAct, pg8::StaticOrder, PG8_ALIGN, PG8_SP2>(F.lds + RING_OFF, g, S, E);
        if (BOTH(1)) GRID_BAR(); }
    if (IN(2)) { for (int u = F.vcu; u < NTOK / 128; u += F.G) mixer_a_unit(F, args, u); if (BOTH(2)) GRID_BAR(); }
    if (IN(3)) { pg8::Gemm g{CAT0, (const bf16*)(ws + WS_WOUT), NTOK, DM, DM}; pg8::StaticOrder S; S.init(NTOK, DM, F.G, (int)blockIdx.x);
        pg8::EpiZ<false> E{args.in[0], Z, ALPHA};
        pg8::gemm_phase<pg8::EpiZ<false>, pg8::StaticOrder, PG8_ALIGN, PG8_SP2>(F.lds + RING_OFF, g, S, E);
        if (BOTH(3)) GRID_BAR(); }
    if (IN(4)) { ln_rows(F, Z, args.in[14], args.in[15], X1); if (BOTH(4)) GRID_BAR(); }
    if (IN(5)) { pg8::Gemm g{X1, (const bf16*)(ws + WS_WFFGU), NTOK, 2 * DFF, DM}; pg8::StaticOrder S; S.init(NTOK, 2 * DFF, F.G, (int)blockIdx.x);
        pg8::EpiSwiglu E{HID, DFF};
        pg8::gemm_phase<pg8::EpiSwiglu, pg8::StaticOrder, PG8_ALIGN, PG8_SP2>(F.lds + RING_OFF, g, S, E);
        if (BOTH(5)) GRID_BAR(); }
    if (IN(6)) { pg8::Gemm g{HID, (const bf16*)(ws + WS_WFFD), NTOK, DM, DFF}; pg8::StaticOrder S; S.init(NTOK, DM, F.G, (int)blockIdx.x);
        pg8::EpiZ<true> E{X1, Z, ALPHA};
        pg8::gemm_phase<pg8::EpiZ<true>, pg8::StaticOrder, PG8_ALIGN, PG8_SP2>(F.lds + RING_OFF, g, S, E);
        if (BOTH(6)) GRID_BAR(); }
    if (IN(7)) { ln_rows(F, Z, args.in[14] + DM, args.in[15] + DM, X2); if (BOTH(7)) GRID_BAR(); }
    if (IN(8)) { pg8::Gemm g{X2, (const bf16*)(ws + WS_WINB), NTOK, NINB, DM}; pg8::StaticOrder S; S.init(NTOK, NINB, F.G, (int)blockIdx.x);
        pg8::EpiAct E{H1, NINB, 0, 0};
        pg8::gemm_phase<pg8::EpiAct, pg8::StaticOrder, PG8_ALIGN, PG8_SP2>(F.lds + RING_OFF, g, S, E);
        if (BOTH(8)) GRID_BAR(); }
    if (IN(9)) { for (int u = F.vcu; u < 1024; u += F.G) ret_kv_unit(F, args, u); if (BOTH(9)) GRID_BAR(); }
    if (IN(10)) { ret_scan(F, args); if (BOTH(10)) GRID_BAR(); }
    if (IN(11)) { for (int u = F.vcu; u < 1024; u += F.G) ret_out_unit(F, args, u); if (BOTH(11)) GRID_BAR(); }
    if (IN(12)) { pg8::Gemm g{CAT1, (const bf16*)(ws + WS_WOUT) + (size_t)DM * DM, NTOK, DM, DM}; pg8::StaticOrder S; S.init(NTOK, DM, F.G, (int)blockIdx.x);
        pg8::EpiZ<true> E{X2, Z, ALPHA};
        pg8::gemm_phase<pg8::EpiZ<true>, pg8::StaticOrder, PG8_ALIGN, PG8_SP2>(F.lds + RING_OFF, g, S, E);
        if (BOTH(12)) GRID_BAR(); }
    if (IN(13)) { ln_router(F, args, Z, args.in[14] + 2 * DM, args.in[15] + 2 * DM, X3); if (BOTH(13)) GRID_BAR(); }
    if (IN(14)) { route_positions(F, args); if (BOTH(14)) GRID_BAR(); }
    if (IN(15)) {
        const int NP = *(const int*)(F.ctl + CW_NP); const int* pe = (const int*)(F.ctl + CW_PE); const int* rowtok = (const int*)(ws + WS_ROWTOK);
        const int slo = args.sub_lo, shi = args.sub_hi;
        for (int p = args.pass_lo; p < args.pass_hi; ++p) { const int p0 = p * PASS_PANELS; int npp = NP - p0; if (npp > PASS_PANELS) npp = PASS_PANELS; if (npp <= 0) break;
            if (slo <= 0 && 0 < shi) { const int gw = F.vcu * NWAVES + F.wave, NGW = F.G * NWAVES;
                for (int r = gw; r < npp * 256; r += NGW) { const int tok = rowtok[p0 * 256 + r]; const GAS v4u* s = (const GAS v4u*)(X3 + (size_t)tok * DM) + F.lane; GAS v4u* d = (GAS v4u*)(XG + (size_t)r * DM) + F.lane;
                    const v4u a = s[0], b = s[64]; d[0] = a; d[64] = b; }
                if (1 < shi) GRID_BAR(); }
            if (slo <= 1 && 1 < shi) { pg8::Gemm g{XG, (const bf16*)(ws + WS_WEGU), npp * 256, 2 * DFFE, DM}; pg8::MoeOrder S; S.init(npp * 256, 2 * DFFE, F.G, (int)blockIdx.x); S.pe = pe + p0; S.nbt = 2 * DFFE / 256;
                pg8::EpiSwiglu E{HIDE, DFFE};
                pg8::gemm_phase<pg8::EpiSwiglu, pg8::MoeOrder, PG8_ALIGN, PG8_SP2>(F.lds + RING_OFF, g, S, E);
                if (2 < shi) GRID_BAR(); }
            if (slo <= 2 && 2 < shi) { pg8::Gemm g{HIDE, (const bf16*)(ws + WS_WED), npp * 256, DM, DFFE}; pg8::MoeOrder S; S.init(npp * 256, DM, F.G, (int)blockIdx.x); S.pe = pe + p0; S.nbt = DM / 256;
                pg8::EpiAct E{YR, DM, 0, p0 * 256};
                pg8::gemm_phase<pg8::EpiAct, pg8::MoeOrder, PG8_ALIGN, PG8_SP2>(F.lds + RING_OFF, g, S, E);
                if (MK_SINGLE) GRID_BAR(); }
        }
    }
    if (IN(16)) { final_rows(F, args); }
#undef IN
#undef BOTH
#undef GRID_BAR
}

extern "C" void kernel_launch(void* const* d_in, const int* in_sizes, int n_in, void* d_out, int out_size, void* d_ws, size_t ws_size, hipStream_t stream) {
    static int grid = 0;
    if (grid == 0) {
        if (n_in != 24 || in_sizes[0] != NTOK * DM || out_size != NTOK * DM || ws_size < WS_END) { fprintf(stderr, "kernel_launch: unexpected shapes (n_in %d, in0 %d, out %d, ws %zu < %zu); nothing launched\n", n_in, n_in > 0 ? in_sizes[0] : -1, out_size, ws_size, (size_t)WS_END); grid = -1; return; }
        int dev = 0, cus = 0, per_cu = 0;
        if (hipGetDevice(&dev) != hipSuccess || hipDeviceGetAttribute(&cus, hipDeviceAttributeMultiprocessorCount, dev) != hipSuccess) { grid = -1; return; }
        if (hipFuncSetAttribute((const void*)hyb_fwd, hipFuncAttributeMaxDynamicSharedMemorySize, LDS_BYTES) != hipSuccess) { fprintf(stderr, "kernel_launch: hipFuncSetAttribute failed\n"); grid = -1; return; }
        if (hipOccupancyMaxActiveBlocksPerMultiprocessor(&per_cu, (const void*)hyb_fwd, NWAVES * 64, LDS_BYTES) != hipSuccess || per_cu < 1)
            fprintf(stderr, "kernel_launch: note: occupancy query reports %d workgroups per CU\n", per_cu);
        (void)hipGetLastError();
        grid = cus;
    }
    if (grid < 0) return;
    if (hipMemsetAsync((char*)d_ws + WS_CTL, 0, CTL_ZERO_BYTES, stream) != hipSuccess) { fprintf(stderr, "kernel_launch: hipMemsetAsync failed\n"); return; }
    Args a{};
    for (int i = 0; i < 24; ++i) a.in[i] = (const float*)d_in[i];
    a.out = (float*)d_out; a.ws = (unsigned char*)d_ws;
#if MK_SINGLE
    a.ph_lo = 0; a.ph_hi = N_PHASES; a.pass_lo = 0; a.pass_hi = MAX_PASSES; a.sub_lo = 0; a.sub_hi = 3; a.li = 0;
    hipLaunchKernelGGL(hyb_fwd, dim3(grid), dim3(NWAVES * 64), LDS_BYTES, stream, a);
#else
    for (int ph = 0; ph < N_PHASES; ++ph) {
        a.ph_lo = ph; a.ph_hi = ph + 1; a.li = 0;
        if (ph != 15) { a.pass_lo = 0; a.pass_hi = 0; a.sub_lo = 0; a.sub_hi = 0; hipLaunchKernelGGL(hyb_fwd, dim3(grid), dim3(NWAVES * 64), LDS_BYTES, stream, a); }
        else for (int p = 0; p < MAX_PASSES; ++p) for (int s = 0; s < 3; ++s) { a.pass_lo = p; a.pass_hi = p + 1; a.sub_lo = s; a.sub_hi = s + 1; hipLaunchKernelGGL(hyb_fwd, dim3(grid), dim3(NWAVES * 64), LDS_BYTES, stream, a); }
    }
#endif
    const hipError_t le = hipPeekAtLastError();
    if (le != hipSuccess) fprintf(stderr, "kernel_launch: launch failed: %s\n", hipGetErrorName(le));
}
```

```cpp
#include <hip/hip_runtime.h>
#include <cstdio>
#include <cstdint>
#include <cmath>
#define REP_MASK 0
#define REP_EPI 0
namespace pg8 {
#define PG8_LAS __attribute__((address_space(3)))
#define PG8_GAS __attribute__((address_space(1)))
typedef unsigned short bf16_t;
typedef short bf16x8 __attribute__((ext_vector_type(8)));
typedef float f32x4 __attribute__((ext_vector_type(4)));
typedef unsigned u32x4 __attribute__((ext_vector_type(4)));
typedef int i32x4 __attribute__((ext_vector_type(4)));
constexpr int BM = 256, BK = 64, HALF = 128, HTB = HALF * BK * 2  , STAGE_BYTES = 8 * HTB, NXCD = 8, WGM = 8;

__host__ __device__ __forceinline__ int lds_byte(int r, int c) { const int st = (r >> 4) * 2 + (c >> 5), rr = r & 15, cc = c & 31, ob = rr * 64 + cc * 2; return st * 1024 + (ob ^ (((ob >> 9) & 1) << 5)); }
__host__ __device__ __forceinline__ void stage_rc(int b, int& R, int& C) { const int st = b / 1024, sb = b % 1024, swz = sb ^ (((sb >> 9) & 1) << 5); R = (st >> 1) * 16 + swz / 64; C = (st & 1) * 32 + (swz % 64) / 2; }
__host__ __device__ __forceinline__ int perm32(int rho) { const int n = rho >> 4, i = rho & 15; return 8 * (i >> 2) + 4 * n + (i & 3); }

struct Unit { int pm, pn, job; };
struct Gemm { const bf16_t* A; const bf16_t* Bt; int M, N, K; int ld; };

struct StaticOrder {
    int nM, nN, nwg, G, c;
    __host__ __device__ void init(int M, int N, int G_, int c_) { nM = M / BM; nN = N / BM; nwg = nM * nN; G = G_; c = c_; }
    __host__ __device__ bool next(int i, Unit& u) const {
        const long L = (long)i * G + c; if (L >= nwg) return false;
        int wgid = (int)L; { const int q = nwg / NXCD, r = nwg % NXCD, xcd = wgid % NXCD, off = wgid / NXCD; wgid = (xcd < r ? xcd * (q + 1) : r * (q + 1) + (xcd - r) * q) + off; }
        const int nig = WGM * nN, gid = wgid / nig, fm = gid * WGM, gsz = (nM - fm) < WGM ? (nM - fm) : WGM;
        u.pm = fm + ((wgid % nig) % gsz); u.pn = (wgid % nig) / gsz; u.job = 0; return true;
    }
    __device__ __forceinline__ const char* a_ptr(const Gemm& g, const Unit& u, size_t tstep) const { return (const char*)g.A + (size_t)u.pm * tstep; }
    __device__ __forceinline__ const char* b_ptr(const Gemm& g, const Unit& u, size_t tstep) const { return (const char*)g.Bt + (size_t)u.pn * tstep; }
    __device__ __forceinline__ int row_token(const Unit& u, int r) const { return u.pm * BM + r; }
    __device__ __forceinline__ void a_ready(const Unit&) const {}
    __device__ __forceinline__ void done(const Unit&) const {}
};

__device__ __forceinline__ unsigned cvt_pk_bf16(float lo, float hi) { unsigned r; asm volatile("v_cvt_pk_bf16_f32 %0, %1, %2" : "=v"(r) : "v"(lo), "v"(hi)); return r; }
typedef float f32x2 __attribute__((ext_vector_type(2)));
__device__ __forceinline__ f32x2 gelu_pk(f32x2 v) {
    const f32x2 av = __builtin_elementwise_abs(v), d = av * 0.2316418882f + 1.0f;
    f32x2 t; t.x = __builtin_amdgcn_rcpf(d.x); t.y = __builtin_amdgcn_rcpf(d.y);
    f32x2 q = t * 0.5307027145f + (-0.7265760135f); q = q * t + 0.7107068705f; q = q * t + (-0.142248368f); q = q * t + 0.127414796f; q = q * t;
    const f32x2 s = (v * v) * (-0.72134752044f);
    f32x2 e; e.x = __builtin_amdgcn_exp2f(s.x); e.y = __builtin_amdgcn_exp2f(s.y);
    const f32x2 m = v * (q * e), r = v - m;
    f32x2 o; o.x = v.x < 0.f ? m.x : r.x; o.y = v.y < 0.f ? m.y : r.y; return o;
}
template <int CTRL> __device__ __forceinline__ float dpp_f(float x) { return __builtin_bit_cast(float, __builtin_amdgcn_update_dpp(0, __builtin_bit_cast(int, x), CTRL, 0xf, 0xf, true)); }
constexpr int DPP_X1 = 0xB1  , DPP_X2 = 0x4E  , DPP_HM = 0x141  , DPP_RM = 0x140  ;
__device__ __forceinline__ float sum8(float v) { v += dpp_f<DPP_X1>(v); v += dpp_f<DPP_X2>(v); v += dpp_f<DPP_HM>(v); return v; }
__device__ __forceinline__ float sum16(float v) { v = sum8(v); v += dpp_f<DPP_RM>(v); return v; }
__device__ __forceinline__ float xsum16(float x) { const auto r = __builtin_amdgcn_permlane16_swap(__float_as_uint(x), __float_as_uint(x), false, false); return __uint_as_float(r[0]) + __uint_as_float(r[1]); }
__device__ __forceinline__ float xsum32(float x) { const auto r = __builtin_amdgcn_permlane32_swap(__float_as_uint(x), __float_as_uint(x), false, false); return __uint_as_float(r[0]) + __uint_as_float(r[1]); }
__device__ __forceinline__ float xmax16(float x) { const auto r = __builtin_amdgcn_permlane16_swap(__float_as_uint(x), __float_as_uint(x), false, false); return fmaxf(__uint_as_float(r[0]), __uint_as_float(r[1])); }
__device__ __forceinline__ float xmax32(float x) { const auto r = __builtin_amdgcn_permlane32_swap(__float_as_uint(x), __float_as_uint(x), false, false); return fmaxf(__uint_as_float(r[0]), __uint_as_float(r[1])); }
__device__ __forceinline__ float silu_f(float x) { return x * __builtin_amdgcn_rcpf(1.0f + __builtin_amdgcn_exp2f(-1.44269504089f * x)); }
struct EpiAct {
    static constexpr bool PERM = true, AFTER_DRAIN = false; static constexpr int NST = 16;
    bf16_t* O; int ldc; int ngelu; int row_off;
    __device__ __forceinline__ void operator()(const f32x4 (&acc)[2][2][4][2], const Unit& u, int wr, int wc, int fr, int fq) const {
        int row0 = row_off + u.pm * BM + wr * 64 + fr; int col0 = u.pn * BM + wc * 32 + 8 * fq; asm volatile("" : "+v"(row0), "+v"(col0));
        const bool act = u.pn < ngelu;
#pragma unroll
        for (int ai = 0; ai < 2; ++ai)
#pragma unroll
            for (int m = 0; m < 4; ++m) { bf16_t* rowp = O + (size_t)(row0 + ai * HALF + m * 16) * ldc + col0;
#pragma unroll
                for (int bj = 0; bj < 2; ++bj) { f32x4 v0 = acc[ai][bj][m][0], v1 = acc[ai][bj][m][1];
                    if (act) { f32x2 a = gelu_pk((f32x2){v0[0], v0[1]}), b = gelu_pk((f32x2){v0[2], v0[3]}), c = gelu_pk((f32x2){v1[0], v1[1]}), d = gelu_pk((f32x2){v1[2], v1[3]});
                        v0 = (f32x4){a.x, a.y, b.x, b.y}; v1 = (f32x4){c.x, c.y, d.x, d.y}; }
                    u32x4 w; w.x = cvt_pk_bf16(v0[0], v0[1]); w.y = cvt_pk_bf16(v0[2], v0[3]); w.z = cvt_pk_bf16(v1[0], v1[1]); w.w = cvt_pk_bf16(v1[2], v1[3]);
                    *(u32x4*)(rowp + bj * HALF) = w; } }
    }
};
struct EpiSwiglu {
    static constexpr bool PERM = true, AFTER_DRAIN = false; static constexpr int NST = 8;
    bf16_t* O; int ldc;
    __device__ __forceinline__ void operator()(const f32x4 (&acc)[2][2][4][2], const Unit& u, int wr, int wc, int fr, int fq) const {
        int row0 = u.pm * BM + wr * 64 + fr; int col0 = u.pn * HALF + wc * 32 + 8 * fq; asm volatile("" : "+v"(row0), "+v"(col0));
#pragma unroll
        for (int ai = 0; ai < 2; ++ai)
#pragma unroll
            for (int m = 0; m < 4; ++m) { bf16_t* rowp = O + (size_t)(row0 + ai * HALF + m * 16) * ldc + col0;
                const f32x4 g0 = acc[ai][0][m][0], g1 = acc[ai][0][m][1], u0 = acc[ai][1][m][0], u1 = acc[ai][1][m][1];
                u32x4 w; w.x = cvt_pk_bf16(silu_f(g0[0]) * u0[0], silu_f(g0[1]) * u0[1]); w.y = cvt_pk_bf16(silu_f(g0[2]) * u0[2], silu_f(g0[3]) * u0[3]);
                w.z = cvt_pk_bf16(silu_f(g1[0]) * u1[0], silu_f(g1[1]) * u1[1]); w.w = cvt_pk_bf16(silu_f(g1[2]) * u1[2], silu_f(g1[3]) * u1[3]);
                *(u32x4*)rowp = w; }
    }
};
struct EpiSwiglu8 {
    static constexpr bool PERM = true, AFTER_DRAIN = false; static constexpr int REP = 2; static constexpr int NST = 4;
    unsigned char* O; int ldc; float qs;
    __device__ __forceinline__ void operator()(const f32x4 (&acc)[2][2][4][2], const Unit& u, int wr, int wc, int fr, int fq) const {
        int row0 = u.pm * BM + wr * 64 + fr; int col0 = u.pn * HALF + wc * 32 + 8 * fq; asm volatile("" : "+v"(row0), "+v"(col0));
        const int radj = (fq & 1) ? 16 : 0, cadj = (fq & 1) ? -8 : 0;
        const float iq2 = 1.0f / (qs * qs), ce = -1.44269504089f * qs, le = __builtin_log2f(iq2);
#pragma unroll
        for (int ai = 0; ai < 2; ++ai)
#pragma unroll
            for (int mp = 0; mp < 2; ++mp) { unsigned char* rowp = O + (size_t)(row0 + ai * HALF + mp * 32 + radj) * ldc + col0 + cadj;
                unsigned w[2][2];
#pragma unroll
                for (int h = 0; h < 2; ++h) { const int m = mp * 2 + h;
                    const f32x4 g0 = __builtin_convertvector(__builtin_bit_cast(i32x4, acc[ai][0][m][0]), f32x4), g1 = __builtin_convertvector(__builtin_bit_cast(i32x4, acc[ai][0][m][1]), f32x4),
                                u0 = __builtin_convertvector(__builtin_bit_cast(i32x4, acc[ai][1][m][0]), f32x4), u1 = __builtin_convertvector(__builtin_bit_cast(i32x4, acc[ai][1][m][1]), f32x4);
#define SWQ(G, U) (((G) * (U)) * __builtin_amdgcn_rcpf(iq2 + __builtin_amdgcn_exp2f((G) * ce + le)))
                    int w0 = __builtin_amdgcn_cvt_pk_fp8_f32(SWQ(g0[0], u0[0]), SWQ(g0[1], u0[1]), 0, false); w0 = __builtin_amdgcn_cvt_pk_fp8_f32(SWQ(g0[2], u0[2]), SWQ(g0[3], u0[3]), w0, true);
                    int w1 = __builtin_amdgcn_cvt_pk_fp8_f32(SWQ(g1[0], u1[0]), SWQ(g1[1], u1[1]), 0, false); w1 = __builtin_amdgcn_cvt_pk_fp8_f32(SWQ(g1[2], u1[2]), SWQ(g1[3], u1[3]), w1, true);
#undef SWQ
                    w[h][0] = (unsigned)w0; w[h][1] = (unsigned)w1; }
                const auto s0 = __builtin_amdgcn_permlane16_swap(w[0][0], w[1][0], false, false), s1 = __builtin_amdgcn_permlane16_swap(w[0][1], w[1][1], false, false);
                *(u32x4*)rowp = (u32x4){s0[0], s1[0], s0[1], s1[1]}; }
    }
};
template <bool BASE_BF16> struct EpiZ {
    static constexpr bool PERM = false, AFTER_DRAIN = false; static constexpr int NST = 32;
    const void* base; float* Z; float alpha;
    __device__ __forceinline__ void operator()(const f32x4 (&acc)[2][2][4][2], const Unit& u, int wr, int wc, int fr, int fq) const {
        int row0 = u.pm * BM + wr * 64 + fr; int col0 = u.pn * BM + wc * 32 + 4 * fq; asm volatile("" : "+v"(row0), "+v"(col0));
#pragma unroll
        for (int ai = 0; ai < 2; ++ai)
#pragma unroll
            for (int m = 0; m < 4; ++m) { const size_t off = (size_t)(row0 + ai * HALF + m * 16) * 1024 + col0;
#pragma unroll
                for (int bj = 0; bj < 2; ++bj)
#pragma unroll
                    for (int n = 0; n < 2; ++n) { const size_t o2 = off + bj * HALF + n * 16; f32x4 b;
                        if (BASE_BF16) { const uint2 r = *(const uint2*)((const bf16_t*)base + o2); b = (f32x4){__uint_as_float(r.x << 16), __uint_as_float(r.x & 0xffff0000u), __uint_as_float(r.y << 16), __uint_as_float(r.y & 0xffff0000u)}; }
                        else b = *(const f32x4*)((const float*)base + o2);
                        *(f32x4*)(Z + o2) = b * alpha + acc[ai][bj][m][n]; } }
    }
};
__device__ __forceinline__ void row_mu_r(const float* ST, int row, float& mu, float& r) {
    const f32x4 a = *(const f32x4*)(ST + (size_t)row * 8), b = *(const f32x4*)(ST + (size_t)row * 8 + 4);
    const float s1 = (a[0] + a[2]) + (b[0] + b[2]), s2 = (a[1] + a[3]) + (b[1] + b[3]);
    mu = s1 * (1.0f / 1024.0f); const float var = s2 * (1.0f / 1024.0f) - mu * mu; r = 1.0f / sqrtf(var + 1e-5f);
}
constexpr int EPIS_REL = 8192;
typedef float f32x2s __attribute__((ext_vector_type(2)));
__device__ __forceinline__ void panel_mu_r(const float* ST, int pm, int t, PG8_LAS unsigned char* lp) {
    const f32x4 v = *(const f32x4*)(ST + (size_t)(pm * BM + (t >> 1)) * 8 + (t & 1) * 4);
    float s1 = v[0] + v[2], s2 = v[1] + v[3]; s1 += dpp_f<DPP_X1>(s1); s2 += dpp_f<DPP_X1>(s2);
    const float mean = s1 * (1.0f / 1024.0f), var = s2 * (1.0f / 1024.0f) - mean * mean;
    if ((t & 1) == 0) *(PG8_LAS f32x2s*)(lp + EPIS_REL + (t >> 1) * 8) = (f32x2s){mean, 1.0f / sqrtf(var + 1e-5f)};
    asm volatile("s_waitcnt lgkmcnt(0)" ::: "memory"); __builtin_amdgcn_s_barrier(); asm volatile("" ::: "memory");
}
__device__ __forceinline__ f32x2s row_mr(PG8_LAS unsigned char* lp, int prow) { return *(const PG8_LAS f32x2s*)(lp + EPIS_REL + prow * 8); }
__device__ __forceinline__ void unpack8(const u32x4 w, f32x4& lo, f32x4& hi) {
    lo = (f32x4){__uint_as_float(w.x << 16), __uint_as_float(w.x & 0xffff0000u), __uint_as_float(w.y << 16), __uint_as_float(w.y & 0xffff0000u)};
    hi = (f32x4){__uint_as_float(w.z << 16), __uint_as_float(w.z & 0xffff0000u), __uint_as_float(w.w << 16), __uint_as_float(w.w & 0xffff0000u)};
}
template <int BASE  , size_t ST_IN, size_t ST_OUT, int LNOFF, bool ZQ = false, size_t ZQ_OFF = 0> struct EpiZs {
    static constexpr bool BASE_LN = BASE == 1;
    static constexpr bool PERM = true, AFTER_DRAIN = false; static constexpr int REP = 1; static constexpr int NST = 16 + (ZQ ? 8 : 0);
    const void* base; bf16_t* Z; unsigned char* sbase; float alpha; PG8_LAS unsigned char* lp;
    __device__ __forceinline__ void operator()(const f32x4 (&acc)[2][2][4][2], const Unit& u, int wr, int wc, int fr, int fq) const {
        int row0 = u.pm * BM + wr * 64 + fr; int col0 = u.pn * BM + wc * 32 + 8 * fq; asm volatile("" : "+v"(row0), "+v"(col0));
        const int prow0 = row0 & 255, tq = (prow0 >> 6) * 256 + (prow0 & 15) + ((col0 >> 5) & 3) * 64 + ((col0 >> 3) & 3) * 16;
        float* const STo = (float*)(sbase + ST_OUT); const float* const STp = (const float*)(sbase + ST_IN);
        const float* g = nullptr; const float* b = nullptr;
        if (BASE_LN) { const volatile PG8_LAS unsigned* pt = (const volatile PG8_LAS unsigned*)(lp - 1024);
            const unsigned g0_ = __builtin_amdgcn_readfirstlane(pt[28]), g1_ = __builtin_amdgcn_readfirstlane(pt[29]), b0_ = __builtin_amdgcn_readfirstlane(pt[30]), b1_ = __builtin_amdgcn_readfirstlane(pt[31]);
            g = (const float*)(((unsigned long long)g1_ << 32) | g0_) + LNOFF; b = (const float*)(((unsigned long long)b1_ << 32) | b0_) + LNOFF; }
        f32x4 gv[2][2], bv[2][2];
        if (BASE_LN) {
#pragma unroll
            for (int bj = 0; bj < 2; ++bj)
#pragma unroll
                for (int n = 0; n < 2; ++n) { gv[bj][n] = *(const f32x4*)(g + col0 + bj * HALF + 4 * n) * alpha; bv[bj][n] = *(const f32x4*)(b + col0 + bj * HALF + 4 * n) * alpha; } }
        typedef float f32x2v __attribute__((ext_vector_type(2)));
        PG8_LAS f32x2v* P = (PG8_LAS f32x2v*)lp;
        if (BASE_LN) panel_mu_r(STp, u.pm, tq, lp);
        f32x4 z[2][4][2][2];
        constexpr int W = BASE_LN ? 8 : 16;
        u32x4 raw[16];
#define EPZ_OFF(k) ((size_t)(row0 + ((k) >> 3) * HALF + (((k) >> 1) & 3) * 16) * 1024 + col0 + ((k) & 1) * HALF)
        if (BASE != 0) {
#pragma unroll
            for (int k = 0; k < W; ++k) raw[k] = *(const u32x4*)((const bf16_t*)base + EPZ_OFF(k)); }
#pragma unroll
        for (int k = 0; k < 16; ++k) { const int ai = k >> 3, m = (k >> 1) & 3, bj = k & 1;
            if (BASE_LN) { const f32x2s mr = row_mr(lp, prow0 + ai * HALF + m * 16); f32x4 p0, p1; unpack8(raw[k], p0, p1);
                z[ai][m][bj][0] = (p0 - mr.x) * mr.y * gv[bj][0] + bv[bj][0] + acc[ai][bj][m][0]; z[ai][m][bj][1] = (p1 - mr.x) * mr.y * gv[bj][1] + bv[bj][1] + acc[ai][bj][m][1]; }
            else if (BASE == 2) { f32x4 p0, p1; unpack8(raw[k], p0, p1); z[ai][m][bj][0] = p0 * alpha + acc[ai][bj][m][0]; z[ai][m][bj][1] = p1 * alpha + acc[ai][bj][m][1]; }
            else { z[ai][m][bj][0] = *(const f32x4*)((const float*)base + EPZ_OFF(k)) * alpha + acc[ai][bj][m][0]; z[ai][m][bj][1] = *(const f32x4*)((const float*)base + EPZ_OFF(k) + 4) * alpha + acc[ai][bj][m][1]; }
            asm volatile("" : "+v"(z[ai][m][bj][0]), "+v"(z[ai][m][bj][1]));
            if (BASE != 0 && k + W < 16) raw[k + W] = *(const u32x4*)((const bf16_t*)base + EPZ_OFF(k + W)); }
#undef EPZ_OFF
        int row0b = row0; asm volatile("" : "+v"(row0b));
#pragma unroll
        for (int ai = 0; ai < 2; ++ai) { unsigned qk[2][2] = {{0u, 0u}, {0u, 0u}};
#pragma unroll
            for (int m = 0; m < 4; ++m) { const int row = row0b + ai * HALF + m * 16; const size_t off = (size_t)row * 1024 + col0;
                float s1 = 0.f, s2 = 0.f;
#pragma unroll
                for (int bj = 0; bj < 2; ++bj) { const f32x4 z0 = z[ai][m][bj][0], z1 = z[ai][m][bj][1];
                    u32x4 w; w.x = cvt_pk_bf16(z0[0], z0[1]); w.y = cvt_pk_bf16(z0[2], z0[3]); w.z = cvt_pk_bf16(z1[0], z1[1]); w.w = cvt_pk_bf16(z1[2], z1[3]);
                    *(u32x4*)(Z + off + bj * HALF) = w;
                    f32x4 y0, y1; unpack8(w, y0, y1);
                    if (ZQ) { unsigned q[8];
#pragma unroll
                        for (int j = 0; j < 4; ++j) { q[j] = (unsigned)(int)__builtin_rintf(fminf(fmaxf(y0[j] * 20.0f, -127.f), 127.f)) & 0xffu; q[4 + j] = (unsigned)(int)__builtin_rintf(fminf(fmaxf(y1[j] * 20.0f, -127.f), 127.f)) & 0xffu; }
                        const unsigned q0 = q[0] | (q[1] << 8) | (q[2] << 16) | (q[3] << 24), q1 = q[4] | (q[5] << 8) | (q[6] << 16) | (q[7] << 24);
                        if ((m & 1) == 0) { qk[bj][0] = q0; qk[bj][1] = q1; }
                        else {
                            const auto t0 = __builtin_amdgcn_permlane16_swap(qk[bj][0], q0, false, false), t1 = __builtin_amdgcn_permlane16_swap(qk[bj][1], q1, false, false);
                            *(u32x4*)(sbase + ZQ_OFF + off + bj * HALF - ((fq & 1) ? 8 : 16 * 1024)) = (u32x4){t0[0], t1[0], t0[1], t1[1]}; } }
                    s1 += ((y0[0] + y0[1]) + (y0[2] + y0[3])) + ((y1[0] + y1[1]) + (y1[2] + y1[3]));
                    s2 += ((y0[0] * y0[0] + y0[1] * y0[1]) + (y0[2] * y0[2] + y0[3] * y0[3])) + ((y1[0] * y1[0] + y1[1] * y1[1]) + (y1[2] * y1[2] + y1[3] * y1[3])); }
                s1 = xsum32(xsum16(s1)); s2 = xsum32(xsum16(s2));
                if (fq == 0) P[(ai * HALF + wr * 64 + m * 16 + fr) * 4 + wc] = (f32x2v){s1, s2}; } }
        asm volatile("s_waitcnt lgkmcnt(0)" ::: "memory"); __builtin_amdgcn_s_barrier(); asm volatile("" ::: "memory");
        const int t = (wr * 4 + wc) * 64 + fq * 16 + fr;
        if (t < 256) { const f32x2v a = P[t * 4 + 0], b2 = P[t * 4 + 1], c = P[t * 4 + 2], d = P[t * 4 + 3];
            *(f32x2v*)(STo + ((size_t)(u.pm * BM + t) * 4 + u.pn) * 2) = (f32x2v){(a.x + b2.x) + (c.x + d.x), (a.y + b2.y) + (c.y + d.y)}; }
    }
};
template <size_t ST_IN, size_t C1_OFF, size_t C2_OFF, bool I8 = false> struct EpiSwigluLN {
    static constexpr bool PERM = true, AFTER_DRAIN = false; static constexpr int NST = 8;
    bf16_t* O; int ldc; unsigned char* sbase; float qs; PG8_LAS unsigned char* lp;
    __device__ __forceinline__ void operator()(const f32x4 (&acc)[2][2][4][2], const Unit& u, int wr, int wc, int fr, int fq) const {
        int row0 = u.pm * BM + wr * 64 + fr; int col0 = u.pn * HALF + wc * 32 + 8 * fq; asm volatile("" : "+v"(row0), "+v"(col0));
        const int prow0 = row0 & 255, tq = (prow0 >> 6) * 256 + (prow0 & 15) + ((col0 >> 5) & 3) * 64 + ((col0 >> 3) & 3) * 16;
        const float* const ST = (const float*)(sbase + ST_IN); const float* const c1 = (const float*)(sbase + C1_OFF); const float* const c2 = (const float*)(sbase + C2_OFF);
        const int cc = u.pn * BM + wc * 32 + 8 * fq;
        f32x4 a1[2][2], a2[2][2];
#pragma unroll
        for (int bj = 0; bj < 2; ++bj)
#pragma unroll
            for (int n = 0; n < 2; ++n) { a1[bj][n] = *(const f32x4*)(c1 + cc + bj * HALF + 4 * n); a2[bj][n] = *(const f32x4*)(c2 + cc + bj * HALF + 4 * n); }
        panel_mu_r(ST, u.pm, tq, lp);
#pragma unroll
        for (int ai = 0; ai < 2; ++ai)
#pragma unroll
            for (int m = 0; m < 4; ++m) { const int row = row0 + ai * HALF + m * 16; bf16_t* rowp = O + (size_t)row * ldc + col0;
                const f32x2s mr = row_mr(lp, prow0 + ai * HALF + m * 16); const float mu = mr.x, r = mr.y;
                f32x4 c00 = acc[ai][0][m][0], c01 = acc[ai][0][m][1], c10 = acc[ai][1][m][0], c11 = acc[ai][1][m][1];
                if (I8) { c00 = __builtin_convertvector(__builtin_bit_cast(i32x4, c00), f32x4) * qs; c01 = __builtin_convertvector(__builtin_bit_cast(i32x4, c01), f32x4) * qs;
                          c10 = __builtin_convertvector(__builtin_bit_cast(i32x4, c10), f32x4) * qs; c11 = __builtin_convertvector(__builtin_bit_cast(i32x4, c11), f32x4) * qs; }
                const f32x4 g0 = (c00 - a1[0][0] * mu) * r + a2[0][0], g1 = (c01 - a1[0][1] * mu) * r + a2[0][1];
                const f32x4 u0 = (c10 - a1[1][0] * mu) * r + a2[1][0], u1 = (c11 - a1[1][1] * mu) * r + a2[1][1];
                u32x4 w; w.x = cvt_pk_bf16(silu_f(g0[0]) * u0[0], silu_f(g0[1]) * u0[1]); w.y = cvt_pk_bf16(silu_f(g0[2]) * u0[2], silu_f(g0[3]) * u0[3]);
                w.z = cvt_pk_bf16(silu_f(g1[0]) * u1[0], silu_f(g1[1]) * u1[1]); w.w = cvt_pk_bf16(silu_f(g1[2]) * u1[2], silu_f(g1[3]) * u1[3]);
                *(u32x4*)rowp = w; }
    }
};
template <size_t ST_IN, size_t C1_OFF, size_t C2_OFF, bool I8 = false> struct EpiLinLN {
    static constexpr bool PERM = true, AFTER_DRAIN = false; static constexpr int NST = 16;
    bf16_t* O; int ldc; unsigned char* sbase; const float* rc; const float* rs; float qs; PG8_LAS unsigned char* lp;
    __device__ __forceinline__ f32x4 cv(const f32x4 a) const { return I8 ? __builtin_convertvector(__builtin_bit_cast(i32x4, a), f32x4) * qs : a; }
    __device__ __forceinline__ void operator()(const f32x4 (&acc)[2][2][4][2], const Unit& u, int wr, int wc, int fr, int fq) const {
        int row0 = u.pm * BM + wr * 64 + fr; int col0 = u.pn * BM + wc * 32 + 8 * fq; asm volatile("" : "+v"(row0), "+v"(col0));
        const int prow0 = row0 & 255, tq = (prow0 >> 6) * 256 + (prow0 & 15) + ((col0 >> 5) & 3) * 64 + ((col0 >> 3) & 3) * 16;
        const float* const ST = (const float*)(sbase + ST_IN); const float* const c1 = (const float*)(sbase + C1_OFF); const float* const c2 = (const float*)(sbase + C2_OFF);
        f32x4 a1[2][2], a2[2][2];
#pragma unroll
        for (int bj = 0; bj < 2; ++bj)
#pragma unroll
            for (int n = 0; n < 2; ++n) { a1[bj][n] = *(const f32x4*)(c1 + col0 + bj * HALF + 4 * n); a2[bj][n] = *(const f32x4*)(c2 + col0 + bj * HALF + 4 * n); }
        panel_mu_r(ST, u.pm, tq, lp);
        if (u.pn < 3) { const int pr0 = u.pn * HALF + wc * 32 + 8 * fq, hd = pr0 / 48, d0 = pr0 - hd * 48; const float sc = hd < 4 ? 0.10206207261596577f : 1.0f;
            f32x4 rot[2][4][4];
#pragma unroll
            for (int ai = 0; ai < 2; ++ai)
#pragma unroll
                for (int m = 0; m < 4; ++m) { const int row = row0 + ai * HALF + m * 16; const f32x2s mr = row_mr(lp, prow0 + ai * HALF + m * 16); const float mu = mr.x, r = mr.y;
                    const f32x4 x0 = ((cv(acc[ai][0][m][0]) - a1[0][0] * mu) * r + a2[0][0]) * sc, x1 = ((cv(acc[ai][0][m][1]) - a1[0][1] * mu) * r + a2[0][1]) * sc;
                    const f32x4 y0 = ((cv(acc[ai][1][m][0]) - a1[1][0] * mu) * r + a2[1][0]) * sc, y1 = ((cv(acc[ai][1][m][1]) - a1[1][1] * mu) * r + a2[1][1]) * sc;
                    const size_t to = (size_t)(row & 8191) * 48 + d0; const f32x4 c0 = *(const f32x4*)(rc + to), c1v = *(const f32x4*)(rc + to + 4), s0 = *(const f32x4*)(rs + to), s1 = *(const f32x4*)(rs + to + 4);
                    rot[ai][m][0] = x0 * c0 - y0 * s0; rot[ai][m][1] = x1 * c1v - y1 * s1; rot[ai][m][2] = y0 * c0 + x0 * s0; rot[ai][m][3] = y1 * c1v + x1 * s1; }
#pragma unroll
            for (int ai = 0; ai < 2; ++ai)
#pragma unroll
                for (int m = 0; m < 4; ++m) { const int row = row0 + ai * HALF + m * 16; const f32x4 o0 = rot[ai][m][0], o1 = rot[ai][m][1], q0 = rot[ai][m][2], q1 = rot[ai][m][3];
                    bf16_t* op = O + (size_t)row * ldc + hd * 96 + d0;
                    u32x4 w; w.x = cvt_pk_bf16(o0[0], o0[1]); w.y = cvt_pk_bf16(o0[2], o0[3]); w.z = cvt_pk_bf16(o1[0], o1[1]); w.w = cvt_pk_bf16(o1[2], o1[3]); *(u32x4*)op = w;
                    w.x = cvt_pk_bf16(q0[0], q0[1]); w.y = cvt_pk_bf16(q0[2], q0[3]); w.z = cvt_pk_bf16(q1[0], q1[1]); w.w = cvt_pk_bf16(q1[2], q1[3]); *(u32x4*)(op + 48) = w; } }
        else {
#pragma unroll
            for (int ai = 0; ai < 2; ++ai)
#pragma unroll
                for (int m = 0; m < 4; ++m) { const int row = row0 + ai * HALF + m * 16; bf16_t* rowp = O + (size_t)row * ldc + col0; const f32x2s mr = row_mr(lp, prow0 + ai * HALF + m * 16); const float mu = mr.x, r = mr.y;
#pragma unroll
                    for (int bj = 0; bj < 2; ++bj) { const f32x4 v0 = (cv(acc[ai][bj][m][0]) - a1[bj][0] * mu) * r + a2[bj][0], v1 = (cv(acc[ai][bj][m][1]) - a1[bj][1] * mu) * r + a2[bj][1];
                        u32x4 w; w.x = cvt_pk_bf16(v0[0], v0[1]); w.y = cvt_pk_bf16(v0[2], v0[3]); w.z = cvt_pk_bf16(v1[0], v1[1]); w.w = cvt_pk_bf16(v1[2], v1[3]);
                        *(u32x4*)(rowp + bj * HALF) = w; } } }
    }
};
struct SplitOrder : StaticOrder {
    const PG8_LAS int* pe; int pm0, npt;
    __device__ __forceinline__ bool next(int i, Unit& u) const { const long x = (long)i * G + c; if (x >= (long)npt * 28) return false;
        const int t = (int)x / 28, rm = (int)x - t * 28; u.pm = pm0 + t; u.pn = rm / 7; u.job = rm - u.pn * 7; return true; }
    __device__ __forceinline__ const char* a_ptr(const Gemm& g, const Unit& u, size_t) const { return (const char*)g.A + u.job * 512; }
    __device__ __forceinline__ const char* b_ptr(const Gemm& g, const Unit& u, size_t tstep) const { return (const char*)g.Bt + (size_t)(pe[u.pm] * 4 + u.pn) * tstep + u.job * 512; }
    __device__ __forceinline__ int row_token(const Unit& u, int r) const { unsigned idx = (unsigned)(u.pm * BM + r); asm volatile("" : "+v"(idx)); return (int)idx; }
};
struct EpiPart {
    static constexpr bool PERM = false, AFTER_DRAIN = false; static constexpr int NST = 32;
    float* P; int pm0;
    __device__ __forceinline__ void operator()(const f32x4 (&acc)[2][2][4][2], const Unit& u, int wr, int wc, int fr, int fq) const {
        int row0 = (u.job * 8 + (u.pm - pm0)) * BM + wr * 64 + fr; int col0 = u.pn * BM + wc * 32 + 4 * fq; asm volatile("" : "+v"(row0), "+v"(col0));
#pragma unroll
        for (int ai = 0; ai < 2; ++ai)
#pragma unroll
            for (int m = 0; m < 4; ++m) { float* rowp = P + (size_t)(row0 + ai * HALF + m * 16) * 1024 + col0;
#pragma unroll
                for (int bj = 0; bj < 2; ++bj)
#pragma unroll
                    for (int n = 0; n < 2; ++n) *(f32x4*)(rowp + bj * HALF + n * 16) = acc[ai][bj][m][n]; }
    }
};
struct P1Order : StaticOrder {
    const bf16_t* memb; const bf16_t* wkv;
    __device__ __forceinline__ bool next(int i, Unit& u) const {
        if (StaticOrder::next(i, u)) return true;
        const long x = (long)i * G + c - nwg; if (x < 0 || x >= 8) return false;
        u.job = 1 + (int)(x >> 2); u.pm = u.job == 1 ? (int)(x & 3) : 0; u.pn = u.job == 1 ? 0 : (int)(x & 3); return true; }
    __device__ __forceinline__ const char* a_ptr(const Gemm& g, const Unit& u, size_t tstep) const { return u.job == 0 ? (const char*)g.A + (size_t)u.pm * tstep : (u.job == 1 ? (const char*)memb + (size_t)u.pm * tstep : (const char*)wkv + tstep); }
    __device__ __forceinline__ const char* b_ptr(const Gemm& g, const Unit& u, size_t tstep) const { return u.job == 0 ? (const char*)g.Bt + (size_t)u.pn * tstep : (u.job == 1 ? (const char*)wkv : (const char*)memb + (size_t)u.pn * tstep); }
};
struct EpiP1 {
    static constexpr bool PERM = true, AFTER_DRAIN = false; static constexpr int NST = 16;
    bf16_t* H0; bf16_t* MK; bf16_t* MVT;
    __device__ __forceinline__ void operator()(const f32x4 (&acc)[2][2][4][2], const Unit& u, int wr, int wc, int fr, int fq) const {
        bf16_t* O = u.job == 0 ? H0 : (u.job == 1 ? MK : MVT); const int ldc = u.job == 0 ? 1792 : (u.job == 1 ? 256 : 1024);
        int row0 = u.pm * BM + wr * 64 + fr; int col0 = u.pn * BM + wc * 32 + 8 * fq; asm volatile("" : "+v"(row0), "+v"(col0));
        const bool act = u.job == 0 && u.pn < 6;
#pragma unroll
        for (int ai = 0; ai < 2; ++ai)
#pragma unroll
            for (int m = 0; m < 4; ++m) { bf16_t* rowp = O + (size_t)(row0 + ai * HALF + m * 16) * ldc + col0;
#pragma unroll
                for (int bj = 0; bj < 2; ++bj) { f32x4 v0 = acc[ai][bj][m][0], v1 = acc[ai][bj][m][1];
                    if (act) { f32x2 a = gelu_pk((f32x2){v0[0], v0[1]}), b = gelu_pk((f32x2){v0[2], v0[3]}), c = gelu_pk((f32x2){v1[0], v1[1]}), d = gelu_pk((f32x2){v1[2], v1[3]});
                        v0 = (f32x4){a.x, a.y, b.x, b.y}; v1 = (f32x4){c.x, c.y, d.x, d.y}; }
                    u32x4 w; w.x = cvt_pk_bf16(v0[0], v0[1]); w.y = cvt_pk_bf16(v0[2], v0[3]); w.z = cvt_pk_bf16(v1[0], v1[1]); w.w = cvt_pk_bf16(v1[2], v1[3]);
                    *(u32x4*)(rowp + bj * HALF) = w; } }
    }
};
struct MoeOrder : StaticOrder {
    const PG8_LAS int* pe; int nbt; const int* rowtok;
    __device__ __forceinline__ const char* a_ptr(const Gemm& g, const Unit&, size_t) const { return (const char*)g.A; }
    __device__ __forceinline__ int row_token(const Unit& u, int r) const { unsigned idx = (unsigned)(u.pm * BM + r); asm volatile("" : "+v"(idx)); return rowtok ? rowtok[idx] : (int)idx; }
    __device__ __forceinline__ const char* b_ptr(const Gemm& g, const Unit& u, size_t tstep) const { return (const char*)g.Bt + (size_t)(pe[u.pm] * nbt + u.pn) * tstep; }
};
template <class T, class = void> struct epi_rep { static constexpr bool value = false; };
template <class T> struct epi_rep<T, decltype((void)T::REP)> { static constexpr bool value = true; };
template <class Epi, class Sched, bool ALIGN_EPI = false, bool SP2 = false, int FP8 = 0  , bool GATHER = false>
__device__ __forceinline__ void gemm_phase(PG8_LAS unsigned char* lds, const Gemm g, const Sched& S, const Epi& E, const int wave_id  ) {
    int tid = wave_id * 64 + (int)__builtin_amdgcn_mbcnt_hi(~0u, __builtin_amdgcn_mbcnt_lo(~0u, 0u)); asm volatile("" : "+v"(tid));
    const int wid = wave_id, lane = tid & 63, wr = wid >> 2, wc = wid & 3, fr = lane & 15, fq = lane >> 4;
    const int K = g.K, nt = K / BK, LD = g.ld ? g.ld : g.K;
    unsigned voffA[2], voffB[2];
#pragma unroll
    for (int i = 0; i < 2; ++i) { int R, C; stage_rc(tid * 16 + i * 8192, R, C); const int Rb = Epi::PERM ? ((R & ~31) + perm32(R & 31)) : R;
        voffA[i] = (unsigned)(R * LD + C) * 2u; voffB[i] = (unsigned)(Rb * LD + C) * 2u; }
    static_assert(SP2 || !GATHER, "GATHER needs the SP2 loop");
    unsigned goff[2][2], ngoff[2][2];
#define PG8_GOFF(dst, unit) do { _Pragma("unroll") for (int _h = 0; _h < 2; ++_h) _Pragma("unroll") for (int _i = 0; _i < 2; ++_i) { int _R, _C; stage_rc(tid * 16 + _i * 8192, _R, _C); \
        dst[_h][_i] = (unsigned)S.row_token(unit, _h * HALF + _R) * (unsigned)(LD * 2) + (unsigned)(_C * 2); } } while (0)
    const size_t kstep = (size_t)(BK * 2);
    const size_t hstep = (size_t)HALF * LD * 2;
    const size_t ahstep = GATHER ? (size_t)0 : hstep;
    const size_t tstep = 2 * hstep;
    const unsigned ldsw = (unsigned)wid * 1024u;
    const int aoff = lds_byte(wr * 64 + fr, fq * 8), boff = lds_byte(wc * 32 + fr, fq * 8);
#define PG8_SA(b, h) (((b) * 2 + (h)) * HTB)
#define PG8_SB(b, h) ((4 + (b) * 2 + (h)) * HTB)
#define PG8_STAGE(bufoff, gbase, voff) do { _Pragma("unroll") for (int _i = 0; _i < 2; ++_i) { unsigned _vo = (voff)[_i]; asm volatile("" : "+v"(_vo)); const PG8_GAS char* _gb = (const PG8_GAS char*)(gbase); asm volatile("" : "+s"(_gb));     \
        __builtin_amdgcn_global_load_lds((const PG8_GAS unsigned*)(_gb + _vo), (PG8_LAS unsigned*)(lds + (bufoff) + ldsw + _i * 8192), 16, 0, 0); } } while (0)
#define PG8_STAGE_A(bufoff, gbase, h) do { if constexpr (GATHER) PG8_STAGE(bufoff, gbase, goff[h]); else PG8_STAGE(bufoff, gbase, voffA); } while (0)
#define PG8_LDA(dst, b, h) do { _Pragma("unroll") for (int m = 0; m < 4; ++m) _Pragma("unroll") for (int k = 0; k < 2; ++k) dst[m][k] = *(const PG8_LAS bf16x8*)(lds + PG8_SA(b, h) + aoff + m * 2048 + k * 1024); } while (0)
#define PG8_LDB(dst, b, h) do { _Pragma("unroll") for (int n = 0; n < 2; ++n) _Pragma("unroll") for (int k = 0; k < 2; ++k) dst[n][k] = *(const PG8_LAS bf16x8*)(lds + PG8_SB(b, h) + boff + n * 2048 + k * 1024); } while (0)
#define PG8_CAT8(x) __builtin_shufflevector(__builtin_bit_cast(i32x4, (x)[0]), __builtin_bit_cast(i32x4, (x)[1]), 0, 1, 2, 3, 4, 5, 6, 7)
#define PG8_MMA(ai, bj, At, Bt) do { __builtin_amdgcn_s_setprio(1); if constexpr (FP8 == 1) { _Pragma("unroll") for (int m = 0; m < 4; ++m) _Pragma("unroll") for (int n = 0; n < 2; ++n) _Pragma("unroll") for (int k = 0; k < 2; ++k) \
        acc[ai][bj][m][n] = __builtin_bit_cast(f32x4, __builtin_amdgcn_mfma_i32_16x16x64_i8(__builtin_bit_cast(i32x4, Bt[n][k]), __builtin_bit_cast(i32x4, At[m][k]), __builtin_bit_cast(i32x4, acc[ai][bj][m][n]), 0, 0, 0)); } else if constexpr (FP8 != 0) { _Pragma("unroll") for (int m = 0; m < 4; ++m) _Pragma("unroll") for (int n = 0; n < 2; ++n) \
        acc[ai][bj][m][n] = __builtin_amdgcn_mfma_scale_f32_16x16x128_f8f6f4(PG8_CAT8(Bt[n]), PG8_CAT8(At[m]), acc[ai][bj][m][n], 0, 0, 0, FP8 * 0x01010101, 0, 0x7F7F7F7F); } else { \
        _Pragma("unroll") for (int m = 0; m < 4; ++m) _Pragma("unroll") for (int n = 0; n < 2; ++n) _Pragma("unroll") for (int k = 0; k < 2; ++k) \
        acc[ai][bj][m][n] = __builtin_amdgcn_mfma_f32_16x16x32_bf16(Bt[n][k], At[m][k], acc[ai][bj][m][n], 0, 0, 0); } __builtin_amdgcn_s_setprio(0); } while (0)
#define PG8_WR() ({ int w_ = wave_id; asm volatile("" : "+s"(w_)); w_ >> 2; })
#define PG8_WAIT_V(n) asm volatile("s_waitcnt vmcnt(" #n ")" ::: "memory")
#define PG8_WAIT_L(n) asm volatile("s_waitcnt lgkmcnt(" #n ")" ::: "memory")
#define PG8_BAR __builtin_amdgcn_s_barrier()
#define PG8_SCHED __builtin_amdgcn_sched_barrier(0)
    Unit cur, nxt; int ui = 0;
    if (!S.next(0, cur)) return;
    f32x4 acc[2][2][4][2];
#pragma unroll
    for (int a = 0; a < 2; ++a)
#pragma unroll
        for (int b = 0; b < 2; ++b)
#pragma unroll
            for (int m = 0; m < 4; ++m)
#pragma unroll
                for (int n = 0; n < 2; ++n) acc[a][b][m][n] = (f32x4){0.f, 0.f, 0.f, 0.f};
    bf16x8 At[4][2], B0[2][2], B1[2][2];
    const char* cA = S.a_ptr(g, cur, tstep); const char* cB = S.b_ptr(g, cur, tstep);
    S.a_ready(cur);
    if constexpr (GATHER) PG8_GOFF(goff, cur);
    if constexpr (SP2) {
        PG8_STAGE(PG8_SB(0, 0), cB, voffB); PG8_STAGE(PG8_SB(0, 1), cB + hstep, voffB); PG8_STAGE_A(PG8_SA(0, 0), cA, 0); PG8_STAGE_A(PG8_SA(0, 1), cA + ahstep, 1);
        if (PG8_WR() == 1) PG8_BAR;
        PG8_WAIT_V(2); PG8_BAR;
        PG8_STAGE(PG8_SB(1, 0), cB + kstep, voffB); PG8_STAGE_A(PG8_SA(1, 0), cA + kstep, 0); PG8_STAGE(PG8_SB(1, 1), cB + hstep + kstep, voffB);
        PG8_WAIT_V(6); PG8_BAR;
    } else {
        PG8_STAGE(PG8_SB(0, 0), cB, voffB); PG8_STAGE(PG8_SA(0, 0), cA, voffA); PG8_STAGE(PG8_SB(0, 1), cB + hstep, voffB); PG8_STAGE(PG8_SA(0, 1), cA + hstep, voffA);
        if (PG8_WR() == 1) PG8_BAR;
        PG8_WAIT_V(4); PG8_BAR;
        PG8_STAGE(PG8_SB(1, 0), cB + kstep, voffB); PG8_STAGE(PG8_SA(1, 0), cA + kstep, voffA); PG8_STAGE(PG8_SB(1, 1), cB + hstep + kstep, voffB);
        PG8_WAIT_V(6); PG8_BAR;
    }
    for (;;) {
        const bool has_next = S.next(ui + 1, nxt);
        const char* nA = has_next ? S.a_ptr(g, nxt, tstep) : cA; const char* nB = has_next ? S.b_ptr(g, nxt, tstep) : cB;
        const bool regather = GATHER && has_next && nxt.pm != cur.pm;
        if constexpr (GATHER) { if (regather) PG8_GOFF(ngoff, nxt); }
#pragma nounroll
        for (int t = 0; t < nt; t += 2) {
            const bool last = (t == nt - 2);
            const char* a1 = cA + (size_t)(t + 1) * kstep;
            const char* a2 = last ? nA : cA + (size_t)(t + 2) * kstep; const char* b2 = last ? nB : cB + (size_t)(t + 2) * kstep;
            const char* a3 = a2 + kstep; const char* b3 = b2 + kstep;
            if (last && has_next) S.a_ready(nxt);
            if constexpr (SP2) {
            const bool relax = (t == 0) && (ui > 0);
#define PG8_WAIT_V8R do { if (relax) asm volatile("s_waitcnt vmcnt(%0)" :: "n"(8 + Epi::NST) : "memory"); else PG8_WAIT_V(8); } while (0)
            PG8_LDB(B0, 0, 0); PG8_LDB(B1, 0, 1); PG8_SCHED; PG8_LDA(At, 0, 0); PG8_STAGE_A(PG8_SA(1, 1), a1 + ahstep, 1);
            if constexpr (GATHER) { if (last && regather) { goff[0][0] = ngoff[0][0]; goff[0][1] = ngoff[0][1]; goff[1][0] = ngoff[1][0]; goff[1][1] = ngoff[1][1]; } }
            PG8_WAIT_V8R; PG8_WAIT_L(0); PG8_BAR; PG8_MMA(0, 0, At, B0); PG8_MMA(0, 1, At, B1); PG8_BAR; PG8_SCHED;
            PG8_LDA(At, 0, 1); PG8_STAGE(PG8_SB(0, 0), b2, voffB); PG8_STAGE(PG8_SB(0, 1), b2 + hstep, voffB); PG8_STAGE_A(PG8_SA(0, 0), a2, 0);
            PG8_WAIT_V8R; PG8_WAIT_L(0); PG8_BAR; PG8_MMA(1, 0, At, B0); PG8_MMA(1, 1, At, B1); PG8_BAR; PG8_SCHED;
            PG8_LDB(B0, 1, 0); PG8_LDB(B1, 1, 1); PG8_SCHED; PG8_LDA(At, 1, 0); PG8_STAGE_A(PG8_SA(0, 1), a2 + ahstep, 1);
            PG8_WAIT_V(8); PG8_WAIT_L(0); PG8_BAR; PG8_MMA(0, 0, At, B0); PG8_MMA(0, 1, At, B1); PG8_BAR; PG8_SCHED;
            PG8_LDA(At, 1, 1); PG8_STAGE(PG8_SB(1, 0), b3, voffB); PG8_STAGE(PG8_SB(1, 1), b3 + hstep, voffB); PG8_STAGE_A(PG8_SA(1, 0), a3, 0);
            PG8_WAIT_V(8); PG8_WAIT_L(0); PG8_BAR; PG8_MMA(1, 0, At, B0); PG8_MMA(1, 1, At, B1); PG8_BAR; PG8_SCHED;
            } else {
            PG8_LDB(B0, 0, 0); PG8_SCHED; PG8_LDA(At, 0, 0); PG8_STAGE(PG8_SA(1, 1), a1 + hstep, voffA);
            PG8_WAIT_L(8); PG8_BAR; PG8_WAIT_L(0); PG8_MMA(0, 0, At, B0); PG8_BAR; PG8_SCHED;
            PG8_LDB(B1, 0, 1); PG8_STAGE(PG8_SB(0, 0), b2, voffB);
            PG8_BAR; PG8_WAIT_L(0); PG8_MMA(0, 1, At, B1); PG8_BAR;
            PG8_LDA(At, 0, 1); PG8_STAGE(PG8_SA(0, 0), a2, voffA);
            PG8_BAR; PG8_WAIT_L(0); PG8_MMA(1, 0, At, B0); PG8_BAR; PG8_SCHED;
            PG8_STAGE(PG8_SB(0, 1), b2 + hstep, voffB);
            PG8_WAIT_V(6); PG8_BAR; PG8_MMA(1, 1, At, B1); PG8_BAR;
            PG8_LDB(B0, 1, 0); PG8_SCHED; PG8_LDA(At, 1, 0); PG8_STAGE(PG8_SA(0, 1), a2 + hstep, voffA);
            PG8_WAIT_L(8); PG8_BAR; PG8_WAIT_L(0); PG8_MMA(0, 0, At, B0); PG8_BAR; PG8_SCHED;
            PG8_LDB(B1, 1, 1); PG8_STAGE(PG8_SB(1, 0), b3, voffB);
            PG8_BAR; PG8_WAIT_L(0); PG8_MMA(0, 1, At, B1); PG8_BAR;
            PG8_LDA(At, 1, 1); PG8_STAGE(PG8_SA(1, 0), a3, voffA);
            PG8_BAR; PG8_WAIT_L(0); PG8_MMA(1, 0, At, B0); PG8_BAR; PG8_SCHED;
            PG8_STAGE(PG8_SB(1, 1), b3 + hstep, voffB);
            PG8_WAIT_V(6); PG8_BAR; PG8_MMA(1, 1, At, B1); PG8_BAR;
            }
        }
        if constexpr (ALIGN_EPI) { if (PG8_WR() == 0) PG8_BAR; }
        if constexpr (!Epi::AFTER_DRAIN) { E(acc, cur, wr, wc, fr, fq);
#if REP_EPI
            if constexpr (epi_rep<Epi>::value) { if constexpr ((Epi::REP & REP_EPI) != 0) { __builtin_amdgcn_s_barrier(); E(acc, cur, wr, wc, fr, fq); } }
#endif
            S.done(cur); }
        if (!has_next) break;
#pragma unroll
        for (int a = 0; a < 2; ++a)
#pragma unroll
            for (int b = 0; b < 2; ++b)
#pragma unroll
                for (int m = 0; m < 4; ++m)
#pragma unroll
                    for (int n = 0; n < 2; ++n) acc[a][b][m][n] = (f32x4){0.f, 0.f, 0.f, 0.f};
        cur = nxt; cA = nA; cB = nB; ++ui;
        if constexpr (ALIGN_EPI) { if (PG8_WR() == 1) PG8_BAR; }
    }
    PG8_WAIT_V(0);
    if constexpr (!ALIGN_EPI) { if (PG8_WR() == 0) PG8_BAR; }
    PG8_BAR;
    if constexpr (Epi::AFTER_DRAIN) { E.fused(acc, cur, wr, wc, fr, fq, lds, wid, lane); S.done(cur); }
#undef PG8_SA
#undef PG8_SB
#undef PG8_STAGE
#undef PG8_LDA
#undef PG8_STAGE_A
#undef PG8_LDB
#undef PG8_MMA
#undef PG8_GOFF
#undef PG8_CAT8
#undef PG8_WAIT_V
#undef PG8_WR
#undef PG8_WAIT_L
#undef PG8_BAR
#undef PG8_SCHED
}
}
#define PG8_SP2 true
#define PG8_ALIGN true
constexpr int NWAVES = 8;
#ifndef MK_SINGLE
#define MK_SINGLE 1
#endif

constexpr int BATCH = 4, SEQ = 8192, DM = 1024, NTOK = BATCH * SEQ;
constexpr int MIXW = 768, MEMW = 256, NMEM = 256;
constexpr int NINA = 2 * MIXW + MEMW;
constexpr int QKW = 384, NINB = 2 * QKW + 2 * MIXW + MEMW;
constexpr int DFF = 2816, DFFE = 3584, NEXP = 8;
constexpr int PASS_PANELS = 128, MAX_PANELS = 264, MAX_PASSES = 2;
constexpr float LN_EPS = 1e-5f, ALPHA = 1.41421356237f;

constexpr size_t MiB = 1u << 20, KiB = 1u << 10;
constexpr size_t WS_CTL = 0, CTL_ZERO_BYTES = 1 * MiB;
constexpr size_t WS_ROPEC = 1 * MiB, WS_ROPES = 2 * MiB + 512 * KiB;
constexpr size_t WS_MEMK = 4 * MiB, WS_MEMVT = 4 * MiB + 512 * KiB;
constexpr size_t WS_SGWB = 5 * MiB;
constexpr size_t WS_TOPI = 5 * MiB + 256 * KiB, WS_GATE = 5 * MiB + 512 * KiB, WS_DEST = 5 * MiB + 768 * KiB, WS_ROWTOK = 6 * MiB;
constexpr size_t WS_PRM = 6 * MiB + 512 * KiB;
constexpr size_t WS_MEMB = 7 * MiB, WS_WMKV = 9 * MiB;
constexpr size_t WS_WINA = 10 * MiB, WS_WINB = WS_WINA + 3 * MiB + 512 * KiB, WS_WOUT = WS_WINB + 5 * MiB, WS_WFFGU = WS_WOUT + 4 * MiB, WS_WFFD = WS_WFFGU + 11 * MiB,
                 WS_WEGU = WS_WFFD + 5 * MiB + 512 * KiB, WS_WED = WS_WEGU + 112 * MiB, WS_ACT = WS_WED + 56 * MiB;
static_assert(WS_ACT == 207 * MiB, "weights map");
constexpr size_t WS_XB = WS_ACT, WS_H0 = WS_ACT + 64 * MiB, WS_CAT0 = WS_ACT + 176 * MiB, WS_X1 = WS_ACT + 240 * MiB;
constexpr size_t WS_HID = WS_ACT, WS_X2 = WS_ACT + 176 * MiB;
constexpr size_t WS_H1 = WS_ACT, WS_CAT1 = WS_ACT + 240 * MiB;
constexpr size_t WS_X3 = WS_ACT, WS_X3Q = WS_ACT + 64 * MiB, WS_YR = WS_ACT + 96 * MiB;
constexpr size_t WS_PARTY = WS_ACT + 232 * MiB;
constexpr size_t WS_END = WS_ACT + 304 * MiB;
static_assert(WS_YR + (size_t)MAX_PANELS * 256 * DM * 2 <= WS_PARTY && WS_PARTY + (size_t)7 * 2048 * DM * 4 <= WS_END, "split-K slabs");
static_assert(WS_YR + (size_t)MAX_PANELS * 256 * DM * 2 <= WS_END && WS_HID + (size_t)NTOK * DFF * 2 <= WS_X2 && WS_H1 + (size_t)NTOK * NINB * 2 <= WS_CAT1, "d_ws map");
constexpr size_t DO_ST1 = 96 * MiB, DO_ST2 = 98 * MiB;
constexpr size_t DO_PART = 104 * MiB, DO_C1 = 106 * MiB, DO_C2 = 106 * MiB + 64 * KiB;
constexpr int NCV = 2 * 2816 + 2560;
constexpr size_t DO_ZQ = 0;
constexpr float WQ_SCALE = 1000.0f, ZQ_SCALE = 20.0f;
constexpr int CW_TMO = 0, CW_CODE = 1;
constexpr int CW_BAR = 4096;
constexpr int CW_HIST = 16384;
constexpr int CW_NP = 20480;
constexpr int CW_PE = 20544;

constexpr int RING_OFF = 0, RING_BYTES = 131072;
constexpr int LDSCTL_OFF = RING_BYTES, MISC_OFF = LDSCTL_OFF + 320;
constexpr int EPIP_OFF = LDSCTL_OFF + 2048;
constexpr int LDS_BYTES = 147456;
static_assert(MISC_OFF + 128 <= LDS_BYTES && EPIP_OFF + 8192 + 2048 <= LDS_BYTES, "LDS map");
#define GAS __attribute__((address_space(1)))
#define LAS __attribute__((address_space(3)))
typedef unsigned short bf16;
typedef unsigned v4u __attribute__((ext_vector_type(4)));
typedef float f32x4 __attribute__((ext_vector_type(4)));
typedef short bf16x8 __attribute__((ext_vector_type(8)));
typedef GAS unsigned gu32;
typedef GAS unsigned long long gu64;
#define RLX_AGENT __ATOMIC_RELAXED, __HIP_MEMORY_SCOPE_AGENT
#define LDS_WAIT() asm volatile("s_waitcnt lgkmcnt(0)" ::: "memory")
#define VM_WAIT() asm volatile("s_waitcnt vmcnt(0)" ::: "memory")
#define LBAR() do { asm volatile("s_waitcnt lgkmcnt(0)" ::: "memory"); __builtin_amdgcn_s_barrier(); asm volatile("" ::: "memory"); } while (0)
__device__ __forceinline__ unsigned long long rt() { return __builtin_amdgcn_s_memrealtime(); }
__device__ __forceinline__ unsigned f2bf(float f) { unsigned u = __builtin_bit_cast(unsigned, f); return (u + 0x7fffu + ((u >> 16) & 1u)) >> 16; }
__device__ __forceinline__ unsigned pk2(float lo, float hi) { return f2bf(lo) | (f2bf(hi) << 16); }

#define XB_TMO      128
#define XB_XCNT(j)  (256  + 64 * (j))
#define XB_XSUB(j)  (1280 + 64 * (j))
#define XB_XGEN(j)  (2304 + 64 * (j))
#define XB_TOP      3328
#define XB_TOPGEN   3392
#define XCD_BAR_WORDS 3456
#define XB_SPIN_CAP (1u << 18)

__device__ __forceinline__ unsigned xb_ld(unsigned* p)              { return __hip_atomic_load(p, __ATOMIC_RELAXED, __HIP_MEMORY_SCOPE_AGENT); }
__device__ __forceinline__ unsigned xb_add(unsigned* p, unsigned v) { return __hip_atomic_fetch_add(p, v, __ATOMIC_RELAXED, __HIP_MEMORY_SCOPE_AGENT); }
__device__ __forceinline__ unsigned xb_xcc_id() { return (unsigned)__builtin_amdgcn_s_getreg((3 << 11) | 20) & 0xFu; }
#define XB_SPIN(cond, bar) do { unsigned _sp = 0; while (cond) { __builtin_amdgcn_s_sleep(1); \
    if ((++_sp & 255u) == 0u) { if (xb_ld(&(bar)[XB_TMO])) break; if (_sp > XB_SPIN_CAP) { atomicAdd(&(bar)[XB_TMO], 1u); break; } } } } while (0)

struct XcdBarrier {
    unsigned* bar; unsigned x;
    volatile LAS unsigned* st;
};

__device__ __forceinline__ XcdBarrier xcd_barrier_post(unsigned* bar, volatile LAS unsigned* st) {
    XcdBarrier b; b.bar = bar; b.x = xb_xcc_id(); b.st = st;
    if (threadIdx.x == 0) (void)xb_add(&bar[XB_XCNT(b.x)], 1u);
    return b;
}
__device__ __forceinline__ void xcd_barrier_complete(unsigned* bar, unsigned x, unsigned& nloc, unsigned& nx) {
    const unsigned G = gridDim.x * gridDim.y * gridDim.z;
    unsigned sum, cnt, mine, sp = 0u;
    for (;;) {
        sum = 0u; cnt = 0u; mine = 0u;
#pragma unroll
        for (unsigned j = 0; j < 16; ++j) { const unsigned c = xb_ld(&bar[XB_XCNT(j)]); sum += c; cnt += (c > 0u) ? 1u : 0u; mine = (j == x) ? c : mine; }
        if (sum == G) break;
        __builtin_amdgcn_s_sleep(1);
        if ((++sp & 255u) == 0u) { if (xb_ld(&bar[XB_TMO])) break; if (sp > XB_SPIN_CAP) { atomicAdd(&bar[XB_TMO], 1u); break; } }
    }
    nloc = mine > 0u ? mine : 1u; nx = cnt > 0u ? cnt : 1u;
}

__device__ __forceinline__ void xcd_barrier(const XcdBarrier& b) {
    asm volatile("s_waitcnt vmcnt(0)" ::: "memory");
    __syncthreads();
    if (threadIdx.x == 0) {
        unsigned* bar = b.bar;
        __builtin_amdgcn_s_waitcnt(0);
        unsigned nloc = b.st[0], nx = b.st[1];
        if (nloc == 0u) { xcd_barrier_complete(bar, b.x, nloc, nx); b.st[0] = nloc; b.st[1] = nx; }
        const unsigned old = xb_add(&bar[XB_XSUB(b.x)], 1u);
        const unsigned gen = old / nloc;
        if (old + 1u == (gen + 1u) * nloc) {
            __builtin_amdgcn_fence(__ATOMIC_RELEASE, "agent");
            asm volatile("s_waitcnt vmcnt(0)" ::: "memory");
            const unsigned og = xb_add(&bar[XB_TOP], 1u);
            const unsigned tg = og / nx;
            if (og + 1u == (tg + 1u) * nx) xb_add(&bar[XB_TOPGEN], 1u);
            else XB_SPIN(xb_ld(&bar[XB_TOPGEN]) == tg, bar);
            __builtin_amdgcn_fence(__ATOMIC_ACQUIRE, "agent");
            xb_add(&bar[XB_XGEN(b.x)], 1u);
            asm volatile("s_waitcnt vmcnt(0)" ::: "memory");
        } else {
            XB_SPIN(xb_ld(&bar[XB_XGEN(b.x)]) == gen, bar);
            __builtin_amdgcn_fence(__ATOMIC_ACQUIRE, "agent");
            asm volatile("s_waitcnt vmcnt(0)" ::: "memory");
        }
    }
    __syncthreads();
}
struct Frame {
    LAS unsigned char* lds;
    volatile LAS unsigned* MISC;
    gu32* ctl;
    int tid, lane, wave;
    int vcu, G;
};
struct Args { const float* in[24]; float* out; unsigned char* ws; int ph_lo, ph_hi, pass_lo, pass_hi, sub_lo, sub_hi, li, pad; };

typedef short bf16x4 __attribute__((ext_vector_type(4)));
using pg8::silu_f;
constexpr int PTR_OFF = LDSCTL_OFF + 1024;
__device__ __forceinline__ const float* inp(const Frame& F, int k) {
    const volatile LAS unsigned* p = (const volatile LAS unsigned*)(F.lds + PTR_OFF) + 2 * k;
    const unsigned lo = __builtin_amdgcn_readfirstlane(p[0]), hi = __builtin_amdgcn_readfirstlane(p[1]);
    return (const float*)(((unsigned long long)hi << 32) | lo);
}
typedef unsigned v2u __attribute__((ext_vector_type(2)));
__device__ __forceinline__ float wave_sum(float v) {
    return pg8::xsum32(pg8::xsum16(pg8::sum16(v)));
}
__device__ __forceinline__ float bflo(unsigned u) { return __uint_as_float(u << 16); }
__device__ __forceinline__ float bfhi(unsigned u) { return __uint_as_float(u & 0xffff0000u); }
__device__ __forceinline__ f32x4 mfma16(bf16x8 a, bf16x8 b, f32x4 c) { return __builtin_amdgcn_mfma_f32_16x16x32_bf16(a, b, c, 0, 0, 0); }
__device__ __forceinline__ bf16x8 lds_frag(const LAS unsigned char* p) { return *(const LAS bf16x8*)p; }
__device__ __forceinline__ bf16x8 lds_frag_split(const LAS unsigned char* lo, const LAS unsigned char* hi) {
    const bf16x4 a = *(const LAS bf16x4*)lo, b = *(const LAS bf16x4*)hi; return __builtin_shufflevector(a, b, 0, 1, 2, 3, 4, 5, 6, 7);
}
__device__ __forceinline__ bf16x8 pack_frag(const f32x4& a, const f32x4& b) {
    v4u w; w.x = pk2(a[0], a[1]); w.y = pk2(a[2], a[3]); w.z = pk2(b[0], b[1]); w.w = pk2(b[2], b[3]); return __builtin_bit_cast(bf16x8, w);
}
__device__ __forceinline__ bf16x8 scale_frag(bf16x8 f, float s) {
    const v4u u = __builtin_bit_cast(v4u, f); v4u w;
    w.x = pk2(bflo(u.x) * s, bfhi(u.x) * s); w.y = pk2(bflo(u.y) * s, bfhi(u.y) * s); w.z = pk2(bflo(u.z) * s, bfhi(u.z) * s); w.w = pk2(bflo(u.w) * s, bfhi(u.w) * s);
    return __builtin_bit_cast(bf16x8, w);
}
#define PIN_OFF(o) asm volatile("" : "+v"(o))
__device__ __forceinline__ v4u gld16(const void* base, unsigned off) { PIN_OFF(off); return *(const GAS v4u*)((const GAS char*)base + off); }
__device__ __forceinline__ v2u gld8(const void* base, unsigned off) { PIN_OFF(off); return *(const GAS v2u*)((const GAS char*)base + off); }
__device__ __forceinline__ float gld4(const void* base, unsigned off) { PIN_OFF(off); return *(const GAS float*)((const GAS char*)base + off); }
__device__ __forceinline__ void gst8(void* base, unsigned off, unsigned long long v) { PIN_OFF(off); *(GAS unsigned long long*)((GAS char*)base + off) = v; }
__device__ __forceinline__ unsigned long long pk4(float a, float b, float c, float d) { return (unsigned long long)pk2(a, b) | ((unsigned long long)pk2(c, d) << 32); }
__device__ __forceinline__ void gst8x2(void* base, unsigned off, unsigned long long a, unsigned long long b, int quad) {
    const auto s0 = __builtin_amdgcn_permlane16_swap((unsigned)a, (unsigned)b, false, false), s1 = __builtin_amdgcn_permlane16_swap((unsigned)(a >> 32), (unsigned)(b >> 32), false, false);
    off += (quad & 1) ? 24u : 0u; PIN_OFF(off); *(GAS v4u*)((GAS char*)base + off) = (v4u){s0[0], s1[0], s0[1], s1[1]};
}

__device__ __forceinline__ void p0_transpose_item(const float* W, int K, int N, bf16* dst, LAS unsigned char* scr, int kb, int nb, int lane, const float* gk, const float* bk, float* part, int dg0, int dg1, int dg2, int dg3, float q8 = 0.f  ) {
    const int k0 = 64 * kb, n0 = 64 * nb, nq = lane & 15, kr = lane >> 4;
    f32x4 v[16];
#pragma unroll
    for (int i = 0; i < 16; ++i) v[i] = __builtin_nontemporal_load((const GAS f32x4*)(W + (size_t)(k0 + 16 * kr + i) * N + n0 + 4 * nq));
    if (gk) {
        f32x4 s1 = (f32x4){0.f, 0.f, 0.f, 0.f}, s2 = s1;
#pragma unroll
        for (int i4 = 0; i4 < 4; ++i4) { const f32x4 gg = *(const GAS f32x4*)(gk + k0 + 16 * kr + 4 * i4), bb = *(const GAS f32x4*)(bk + k0 + 16 * kr + 4 * i4);
#pragma unroll
            for (int j = 0; j < 4; ++j) { s2 += v[4 * i4 + j] * bb[j]; v[4 * i4 + j] = v[4 * i4 + j] * gg[j]; s1 += v[4 * i4 + j]; } }
#pragma unroll
        for (int c = 0; c < 4; ++c) { s1[c] = pg8::xsum32(pg8::xsum16(s1[c])); s2[c] = pg8::xsum32(pg8::xsum16(s2[c])); }
        if (kr == 0) { const int gsel = nq >> 2, dgr = gsel == 0 ? dg0 : (gsel == 1 ? dg1 : (gsel == 2 ? dg2 : dg3)); float* q = part + ((size_t)kb * NCV + dgr + (4 * nq & 15)) * 2; *(GAS f32x4*)q = (f32x4){s1[0], s2[0], s1[1], s2[1]}; *(GAS f32x4*)(q + 4) = (f32x4){s1[2], s2[2], s1[3], s2[3]}; } }
    if (q8 != 0.f) {
#pragma unroll
        for (int c = 0; c < 4; ++c) { unsigned q[16];
#pragma unroll
            for (int i = 0; i < 16; ++i) q[i] = (unsigned)(int)__builtin_rintf(fminf(fmaxf(v[i][c] * q8, -127.f), 127.f)) & 0xffu;
            v4u a; a.x = q[0] | (q[1] << 8) | (q[2] << 16) | (q[3] << 24); a.y = q[4] | (q[5] << 8) | (q[6] << 16) | (q[7] << 24); a.z = q[8] | (q[9] << 8) | (q[10] << 16) | (q[11] << 24); a.w = q[12] | (q[13] << 8) | (q[14] << 16) | (q[15] << 24);
            *(LAS v4u*)(scr + (c * 16 + nq) * 80 + kr * 16) = a; }
        LDS_WAIT(); asm volatile("" ::: "memory");
#pragma unroll
        for (int r = 0; r < 4; ++r) { const int id = lane + 64 * r, c4 = id & 3, rho = id >> 2, n = (rho & 15) * 4 + (rho >> 4), gsel = n >> 4;
            const int row = (gsel == 0 ? dg0 : (gsel == 1 ? dg1 : (gsel == 2 ? dg2 : dg3))) + (n & 15);
            *(GAS v4u*)((unsigned char*)dst + (size_t)row * K + k0 + 16 * c4) = *(const LAS v4u*)(scr + rho * 80 + c4 * 16); }
        LDS_WAIT(); asm volatile("" ::: "memory");
        return; }
#pragma unroll
    for (int c = 0; c < 4; ++c) { v4u a, b;
        a.x = pk2(v[0][c], v[1][c]); a.y = pk2(v[2][c], v[3][c]); a.z = pk2(v[4][c], v[5][c]); a.w = pk2(v[6][c], v[7][c]);
        b.x = pk2(v[8][c], v[9][c]); b.y = pk2(v[10][c], v[11][c]); b.z = pk2(v[12][c], v[13][c]); b.w = pk2(v[14][c], v[15][c]);
        LAS unsigned char* q = scr + (c * 16 + nq) * 144 + kr * 32; *(LAS v4u*)q = a; *(LAS v4u*)(q + 16) = b; }
    LDS_WAIT(); asm volatile("" ::: "memory");
#pragma unroll
    for (int r = 0; r < 8; ++r) { const int id = lane + 64 * r, c8 = id & 7, rho = id >> 3, n = (rho & 15) * 4 + (rho >> 4), gsel = n >> 4;
        const int row = (gsel == 0 ? dg0 : (gsel == 1 ? dg1 : (gsel == 2 ? dg2 : dg3))) + (n & 15);
        *(GAS v4u*)(dst + (size_t)row * K + k0 + 8 * c8) = *(const LAS v4u*)(scr + rho * 144 + c8 * 16); }
    LDS_WAIT(); asm volatile("" ::: "memory");
}
__device__ __forceinline__ unsigned pk_i8x4(float a, float b, float c, float d) {
    const unsigned q0 = (unsigned)(int)__builtin_rintf(fminf(fmaxf(a, -127.f), 127.f)) & 0xffu, q1 = (unsigned)(int)__builtin_rintf(fminf(fmaxf(b, -127.f), 127.f)) & 0xffu,
                   q2 = (unsigned)(int)__builtin_rintf(fminf(fmaxf(c, -127.f), 127.f)) & 0xffu, q3 = (unsigned)(int)__builtin_rintf(fminf(fmaxf(d, -127.f), 127.f)) & 0xffu;
    return q0 | (q1 << 8) | (q2 << 16) | (q3 << 24); }
__device__ __forceinline__ unsigned pk_fp8x4(float a, float b, float c, float d) { int w = __builtin_amdgcn_cvt_pk_fp8_f32(a, b, 0, false); w = __builtin_amdgcn_cvt_pk_fp8_f32(c, d, w, true); return (unsigned)w; }
struct ExpHalf { const float* src; unsigned char* dst; int N, K, hh; float sc; bool i8; };
__device__ __forceinline__ bool exp_half(int q, int gw, int NGW, const float* wg, const float* wu, const float* wd, unsigned char* ws, ExpHalf& H) {
    const int it = gw + NGW * (q >> 1); if (it >= 24 * 448) return false;
    const int j = it / 448, r = it - j * 448, e = j & 7, kind = j >> 3; H.hh = q & 1;
    H.i8 = kind != 2;
    if (kind == 2) { const int kb = r >> 4, nb = r & 15; H.N = DM; H.K = DFFE; H.sc = 128.0f;
        H.src = wd + (size_t)e * DFFE * DM + (size_t)(128 * kb + 64 * H.hh) * DM + 64 * nb; H.dst = ws + WS_WED + ((size_t)e * DM + 64 * nb) * DFFE + 128 * kb; }
    else { const int kb = r / 56, nb = r - kb * 56, n0 = 64 * nb; H.N = DFFE; H.K = DM; H.sc = WQ_SCALE;
        H.src = (kind ? wu : wg) + (size_t)e * DM * DFFE + (size_t)(128 * kb + 64 * H.hh) * DFFE + n0;
        H.dst = ws + WS_WEGU + ((size_t)e * 2 * DFFE + (n0 >> 7) * 256 + (n0 & 127) + (kind ? 128 : 0)) * DM + 128 * kb; }
    return true;
}
__device__ __forceinline__ void exp_load(f32x4 (&v)[16], const ExpHalf& H, int lane) {
    const int nq = lane & 15, kr = lane >> 4;
#pragma unroll
    for (int i = 0; i < 16; ++i) v[i] = __builtin_nontemporal_load((const GAS f32x4*)(H.src + (size_t)(16 * kr + i) * H.N + 4 * nq));
}
__device__ __forceinline__ void exp_process(const f32x4 (&v)[16], const ExpHalf& H, LAS unsigned char* scr, int lane) {
    const int nq = lane & 15, kr = lane >> 4;
#pragma unroll
    for (int c = 0; c < 4; ++c) { v4u a;
        if (H.i8) { a.x = pk_i8x4(v[0][c] * H.sc, v[1][c] * H.sc, v[2][c] * H.sc, v[3][c] * H.sc); a.y = pk_i8x4(v[4][c] * H.sc, v[5][c] * H.sc, v[6][c] * H.sc, v[7][c] * H.sc);
            a.z = pk_i8x4(v[8][c] * H.sc, v[9][c] * H.sc, v[10][c] * H.sc, v[11][c] * H.sc); a.w = pk_i8x4(v[12][c] * H.sc, v[13][c] * H.sc, v[14][c] * H.sc, v[15][c] * H.sc); }
        else { a.x = pk_fp8x4(v[0][c] * H.sc, v[1][c] * H.sc, v[2][c] * H.sc, v[3][c] * H.sc); a.y = pk_fp8x4(v[4][c] * H.sc, v[5][c] * H.sc, v[6][c] * H.sc, v[7][c] * H.sc);
            a.z = pk_fp8x4(v[8][c] * H.sc, v[9][c] * H.sc, v[10][c] * H.sc, v[11][c] * H.sc); a.w = pk_fp8x4(v[12][c] * H.sc, v[13][c] * H.sc, v[14][c] * H.sc, v[15][c] * H.sc); }
        *(LAS v4u*)(scr + (c * 16 + nq) * 144 + H.hh * 64 + kr * 16) = a; }
    if (H.hh == 1) { LDS_WAIT(); asm volatile("" ::: "memory");
#pragma unroll
        for (int r = 0; r < 8; ++r) { const int id = lane + 64 * r, c8 = id & 7, rho = id >> 3, n = (rho & 15) * 4 + (rho >> 4);
            *(GAS v4u*)(H.dst + (size_t)n * H.K + 16 * c8) = *(const LAS v4u*)(scr + rho * 144 + c8 * 16); }
        LDS_WAIT(); asm volatile("" ::: "memory"); }
}
__device__ __forceinline__ void rows_load(f32x4 (&v)[16], const float* src, int m, int lane) {
#pragma unroll
    for (int r = 0; r < 4; ++r)
#pragma unroll
        for (int j = 0; j < 4; ++j) v[4 * r + j] = __builtin_nontemporal_load((const GAS f32x4*)(src + (size_t)(m + r) * DM) + lane + 64 * j);
}
__device__ __forceinline__ void rows_store(const f32x4 (&v)[16], bf16* dst, int m, int lane) {
#pragma unroll
    for (int r = 0; r < 4; ++r)
#pragma unroll
        for (int j = 0; j < 4; ++j) ((GAS unsigned long long*)(dst + (size_t)(m + r) * DM))[lane + 64 * j] = pk4(v[4 * r + j].x, v[4 * r + j].y, v[4 * r + j].z, v[4 * r + j].w);
}
__device__ __forceinline__ void p0_rows_to_bf16(const float* src, bf16* dst, int nrows, int gw, int NGW, int lane) {
    f32x4 va[16], vb[16]; int m = 4 * gw; const int st = 4 * NGW;
    if (m < nrows) rows_load(va, src, m, lane);
    for (; m < nrows; m += 2 * st) {
        if (m + st < nrows) rows_load(vb, src, m + st, lane);
        rows_store(va, dst, m, lane);
        if (m + 2 * st < nrows) rows_load(va, src, m + 2 * st, lane);
        if (m + st < nrows) rows_store(vb, dst, m + st, lane); }
}
__device__ __forceinline__ void p0_prologue(Frame& F, const Args& A) {
    unsigned char* ws = A.ws;
    const float* const in0 = inp(F, 0); const float* const in1 = inp(F, 1); const float* const in2 = inp(F, 2); const float* const in3 = inp(F, 3); const float* const in6 = inp(F, 6); const float* const in8 = inp(F, 8);
    const float* const lng_ = inp(F, 14); const float* const lnb_ = inp(F, 15);
    const float* const in13 = inp(F, 13); const float* const in16 = inp(F, 16); const float* const in17 = inp(F, 17); const float* const in18 = inp(F, 18); const float* const in21 = inp(F, 21); const float* const in22 = inp(F, 22); const float* const in23 = inp(F, 23);
    LAS unsigned char* scr = F.lds + RING_OFF + F.wave * 16384;
    const int gw = F.vcu * NWAVES + F.wave, NGW = F.G * NWAVES;
    const int gt = F.vcu * (NWAVES * 64) + F.tid, NGT = F.G * NWAVES * 64;
    constexpr int I_INA = 16 * 28, I_INB = 16 * 40, I_OUT = 16 * 16, I_FF = 16 * 44, I_FFD = 44 * 16, I_MKV = 16 * 8, I_EX = 896, I_EX8 = 448;
    constexpr int NSMALL = I_INA + I_INB + 2 * I_OUT + 2 * I_FF + I_FFD + I_MKV;
    for (int it = gw; it < NSMALL; it += NGW) {
        int r = it; const float* src; bf16* dst; int K, N, kind = 0, fold = 0;
        if (r < I_INA) { src = in3; dst = (bf16*)(ws + WS_WINA); K = DM; N = NINA; }
        else if ((r -= I_INA) < I_INB) { src = in8; dst = (bf16*)(ws + WS_WINB); K = DM; N = NINB; fold = 2; }
        else if ((r -= I_INB) < 2 * I_OUT) { const int l = r / I_OUT; r -= l * I_OUT; src = in13 + (size_t)l * DM * DM; dst = (bf16*)(ws + WS_WOUT) + (size_t)l * DM * DM; K = DM; N = DM; }
        else if ((r -= 2 * I_OUT) < I_FF) { src = in16; dst = (bf16*)(ws + WS_WFFGU); K = DM; N = DFF; kind = 1; fold = 1; }
        else if ((r -= I_FF) < I_FF) { src = in17; dst = (bf16*)(ws + WS_WFFGU); K = DM; N = DFF; kind = 2; fold = 1; }
        else if ((r -= I_FF) < I_FFD) { src = in18; dst = (bf16*)(ws + WS_WFFD); K = DFF; N = DM; }
        else { r -= I_FFD; src = in2; dst = (bf16*)(ws + WS_WMKV); K = DM; N = 512; }
        const int nblk = N / 64, kb = r / nblk, nb = r % nblk, n0 = 64 * nb;
        const int drow = kind == 0 ? n0 : ((n0 >> 7) * 256 + (n0 & 127) + (kind == 2 ? 128 : 0));
        int dg[4];
#pragma unroll
        for (int gi = 0; gi < 4; ++gi) { dg[gi] = drow + 16 * gi;
            if (fold == 2 && n0 < 2 * QKW) { const int n = n0 + 16 * gi, hd = n / 96, d = n - hd * 96, pr = hd * 48 + (d >= 48 ? d - 48 : d);
                dg[gi] = (pr >> 7) * 256 + (d >= 48 ? 128 : 0) + (pr & 127); } }
        const float* gk = fold ? lng_ + (fold - 1) * DM : nullptr; const float* bk = lnb_ + (fold ? fold - 1 : 0) * DM;
        p0_transpose_item(src, K, N, dst, scr, kb, nb, F.lane, gk, bk, (float*)((unsigned char*)A.out + DO_PART) + (size_t)(fold == 2 ? 2 * DFF : 0) * 2, dg[0], dg[1], dg[2], dg[3], fold ? WQ_SCALE : 0.f);
    }
    { f32x4 va[16], vb[16]; ExpHalf Ha, Hb; int q = 0;
      bool oka = exp_half(q, gw, NGW, in21, in22, in23, ws, Ha); if (oka) exp_load(va, Ha, F.lane);
      while (oka) { const bool okb = exp_half(q + 1, gw, NGW, in21, in22, in23, ws, Hb); if (okb) exp_load(vb, Hb, F.lane);
          exp_process(va, Ha, scr, F.lane);
          oka = okb && exp_half(q + 2, gw, NGW, in21, in22, in23, ws, Ha); if (oka) exp_load(va, Ha, F.lane);
          if (okb) exp_process(vb, Hb, scr, F.lane);
          q += 2; } }
    p0_rows_to_bf16(in0, (bf16*)(ws + WS_XB), NTOK, gw, NGW, F.lane);
    p0_rows_to_bf16(in1, (bf16*)(ws + WS_MEMB), BATCH * NMEM, gw, NGW, F.lane);
    { const float* sgw = in6; bf16* SG = (bf16*)(ws + WS_SGWB);
      for (int i = gt; i < 8 * 128 * 128 / 4; i += NGT) { const f32x4 v = ((const GAS f32x4*)sgw)[i]; ((GAS unsigned long long*)SG)[i] = pk4(v.x, v.y, v.z, v.w); }
      float* rc = (float*)(ws + WS_ROPEC); float* rs = (float*)(ws + WS_ROPES);
      for (int i = gt; i < SEQ * 48; i += NGT) { const int pos = i / 48, k = i - pos * 48;
          const float inv = __builtin_amdgcn_exp2f(-((float)(2 * k) / 96.0f) * 13.287712379549449f);
          const float ang = (float)pos * inv;
          double rev = (double)ang * 0.15915494309189535; rev -= __builtin_rint(rev);
          rc[i] = __builtin_amdgcn_cosf((float)rev); rs[i] = __builtin_amdgcn_sinf((float)rev); }
      int* rowtok = (int*)(ws + WS_ROWTOK);
      for (int i = gt; i < MAX_PANELS * 256; i += NGT) rowtok[i] = 0;
      if (gt < 8) { const float lg = (gt < 4) ? inp(F, 9)[gt] : inp(F, 10)[gt - 4];
          const double ls = -log1p(exp(-(double)lg));
          ((float*)(ws + WS_PRM))[gt] = (float)(ls * 1.4426950408889634); }
    }
}

struct AttnRegs { v4u q[2], k[4], v[4]; };
__device__ __forceinline__ void attn_issue(AttnRegs& R, int tid, const bf16* qb, int ldq, int b, int hh, int t0, const bf16* MK, const bf16* MVT) {
#pragma unroll
    for (int i = 0; i < 2; ++i) { const int id = tid + 512 * i, row = id >> 3, ch = id & 7; R.q[i] = gld16(qb + (size_t)t0 * ldq, (unsigned)(row * ldq + ch * 8) * 2u); }
#pragma unroll
    for (int i = 0; i < 4; ++i) { const int id = tid + 512 * i, row = id >> 3, ch = id & 7; R.k[i] = gld16(MK + (size_t)b * 65536 + hh * 64, (unsigned)(row * 256 + ch * 8) * 2u); }
#pragma unroll
    for (int i = 0; i < 4; ++i) { const int id = tid + 512 * i, row = id >> 5, ch = id & 31; R.v[i] = gld16(MVT + (size_t)hh * 65536 + b * 256, (unsigned)(row * 1024 + ch * 8) * 2u); }
}
__device__ __forceinline__ void attn_commit(Frame& F, const AttnRegs& R) {
    LAS unsigned char* QS = F.lds + RING_OFF; LAS unsigned char* KS = QS + 128 * 144; LAS unsigned char* VT = KS + 256 * 144; const int tid = F.tid;
#pragma unroll
    for (int i = 0; i < 2; ++i) { const int id = tid + 512 * i, row = id >> 3, ch = id & 7; *(LAS v4u*)(QS + row * 144 + ch * 16) = R.q[i]; }
#pragma unroll
    for (int i = 0; i < 4; ++i) { const int id = tid + 512 * i, row = id >> 3, ch = id & 7; *(LAS v4u*)(KS + row * 144 + ch * 16) = R.k[i]; }
#pragma unroll
    for (int i = 0; i < 4; ++i) { const int id = tid + 512 * i, row = id >> 5, ch = id & 31; *(LAS v4u*)(VT + row * 528 + ch * 16) = R.v[i]; }
}
__device__ __forceinline__ void attn_compute(Frame& F, int t0, bf16* CAT, int ocol) {
    LAS unsigned char* QS = F.lds + RING_OFF; LAS unsigned char* KS = QS + 128 * 144; LAS unsigned char* VT = KS + 256 * 144;
    const int lane = F.lane, r16 = lane & 15, quad = lane >> 4, w = F.wave;
    f32x4 s[16];
#pragma unroll
    for (int mt = 0; mt < 16; ++mt) s[mt] = (f32x4){0.f, 0.f, 0.f, 0.f};
#pragma unroll
    for (int ks = 0; ks < 2; ++ks) { const bf16x8 qf = lds_frag(QS + (16 * w + r16) * 144 + ks * 64 + quad * 16);
#pragma unroll
        for (int mt = 0; mt < 16; ++mt) s[mt] = mfma16(lds_frag(KS + (16 * mt + r16) * 144 + ks * 64 + quad * 16), qf, s[mt]); }
    float mx = -3.0e38f;
#pragma unroll
    for (int mt = 0; mt < 16; ++mt) { mx = fmaxf(mx, fmaxf(fmaxf(s[mt][0], s[mt][1]), fmaxf(s[mt][2], s[mt][3]))); }
    mx = pg8::xmax32(pg8::xmax16(mx));
    const float c = 0.125f * 1.44269504089f; float sum = 0.f;
#pragma unroll
    for (int mt = 0; mt < 16; ++mt) {
#pragma unroll
        for (int j = 0; j < 4; ++j) { const float e = __builtin_amdgcn_exp2f((s[mt][j] - mx) * c); s[mt][j] = e; sum += e; } }
    sum = pg8::xsum32(pg8::xsum16(sum));
    const float inv = 1.0f / sum;
    f32x4 o[4];
#pragma unroll
    for (int dt = 0; dt < 4; ++dt) o[dt] = (f32x4){0.f, 0.f, 0.f, 0.f};
#pragma unroll
    for (int st = 0; st < 8; ++st) { const bf16x8 pf = pack_frag(s[2 * st] * inv, s[2 * st + 1] * inv);
#pragma unroll
        for (int dt = 0; dt < 4; ++dt) { const LAS unsigned char* vp = VT + (16 * dt + r16) * 528 + (32 * st + 4 * quad) * 2;
            o[dt] = mfma16(lds_frag_split(vp, vp + 32), pf, o[dt]); } }
    bf16* opb = CAT + (size_t)t0 * DM + ocol; const unsigned opo = (unsigned)((16 * w + r16) * DM + 4 * quad) * 2u;
#pragma unroll
    for (int dt = 0; dt < 4; dt += 2) gst8x2(opb, opo + 32u * dt, pk4(o[dt][0], o[dt][1], o[dt][2], o[dt][3]), pk4(o[dt + 1][0], o[dt + 1][1], o[dt + 1][2], o[dt + 1][3]), quad);
}

__device__ __forceinline__ void mixer_a_unit(Frame& F, const Args& A, int unit) {
    unsigned char* ws = A.ws;
    const bf16* H0 = (const bf16*)(ws + WS_H0); bf16* CAT = (bf16*)(ws + WS_CAT0); const bf16* SG = (const bf16*)(ws + WS_SGWB);
    const float* lng = inp(F, 4); const float* lnb = inp(F, 5); const float* sgb = inp(F, 7);
    const int t0 = unit * 128, tid = F.tid, lane = F.lane, r16 = lane & 15, quad = lane >> 4, w = F.wave, b = t0 / SEQ;
    LAS float* STAT = (LAS float*)(F.lds + RING_OFF);
    LAS unsigned char* WS_ = F.lds + RING_OFF + 1024;
    LAS unsigned char* VT = WS_ + 128 * 272;
    LAS float* LNG = (LAS float*)(VT + 96 * 272); LAS float* LNB = LNG + MIXW;
    static_assert(1024 + 128 * 272 + 96 * 272 + 2 * MIXW * 4 <= RING_BYTES, "P2 LDS map");
    v4u gw_[4], gv_[3]; v2u gu_[6];
#define MIX_ISSUE(g) do { _Pragma("unroll") for (int i = 0; i < 4; ++i) { const int id = tid + 512 * i, p = id >> 4, ch = id & 15; gw_[i] = gld16(SG + (size_t)(g) * 16384, (unsigned)(p * 128 + ch * 8) * 2u); } \
        _Pragma("unroll") for (int i = 0; i < 3; ++i) { const int id = tid + 512 * i, q = id & 127, cc = id >> 7; gv_[i] = gld16(H0 + (size_t)t0 * NINA + MIXW + (g) * 96, (unsigned)(q * NINA + cc * 8) * 2u); } \
        _Pragma("unroll") for (int ct = 0; ct < 6; ++ct) gu_[ct] = gld8(H0 + (size_t)t0 * NINA + (g) * 96, (unsigned)((16 * w + r16) * NINA + 4 * quad + 16 * ct) * 2u); } while (0)
    { const bool two = tid + NWAVES * 64 < MIXW;
      const float g0_ = gld4(lng, (unsigned)tid * 4u), b0_ = gld4(lnb, (unsigned)tid * 4u), g1_ = two ? gld4(lng, (unsigned)(tid + NWAVES * 64) * 4u) : 0.f, b1_ = two ? gld4(lnb, (unsigned)(tid + NWAVES * 64) * 4u) : 0.f;
      LNG[tid] = g0_; LNB[tid] = b0_; if (two) { LNG[tid + NWAVES * 64] = g1_; LNB[tid + NWAVES * 64] = b1_; } }
    float bias_[8];
#pragma unroll
    for (int g = 0; g < 8; ++g) bias_[g] = gld4(sgb, (unsigned)(g * 128 + 16 * w + r16) * 4u);
    MIX_ISSUE(0);
    v2u rall[16][3];
#pragma unroll
    for (int k = 0; k < 16; ++k) { const bf16* vp = H0 + (size_t)(t0 + 16 * w + k) * NINA + MIXW;
#pragma unroll
        for (int j = 0; j < 3; ++j) rall[k][j] = gld8(vp, (unsigned)(4 * lane + 256 * j) * 2u); }
#pragma unroll
    for (int rr = 0; rr < 16; rr += 4) { v2u r[4][3];
#pragma unroll
        for (int k = 0; k < 4; ++k)
#pragma unroll
            for (int j = 0; j < 3; ++j) r[k][j] = rall[rr + k][j];
        float sm[4], q[4];
#pragma unroll
        for (int k = 0; k < 4; ++k) { sm[k] = 0.f;
#pragma unroll
            for (int j = 0; j < 3; ++j) sm[k] += (bflo(r[k][j].x) + bfhi(r[k][j].x)) + (bflo(r[k][j].y) + bfhi(r[k][j].y)); }
#pragma unroll
        for (int k = 0; k < 4; ++k) sm[k] = wave_sum(sm[k]);
#pragma unroll
        for (int k = 0; k < 4; ++k) { const float mean = sm[k] * (1.0f / 768.0f); sm[k] = mean; q[k] = 0.f;
#pragma unroll
            for (int j = 0; j < 3; ++j) { const float d0 = bflo(r[k][j].x) - mean, d1 = bfhi(r[k][j].x) - mean, d2 = bflo(r[k][j].y) - mean, d3 = bfhi(r[k][j].y) - mean; q[k] += (d0 * d0 + d1 * d1) + (d2 * d2 + d3 * d3); } }
#pragma unroll
        for (int k = 0; k < 4; ++k) q[k] = wave_sum(q[k]);
        if (lane == 0) {
#pragma unroll
            for (int k = 0; k < 4; ++k) { STAT[2 * (16 * w + rr + k)] = sm[k]; STAT[2 * (16 * w + rr + k) + 1] = 1.0f / sqrtf(q[k] * (1.0f / 768.0f) + LN_EPS); } } }
    LBAR();
    for (int g = 0; g < 8; ++g) {
#pragma unroll
        for (int i = 0; i < 4; ++i) { const int id = tid + 512 * i, p = id >> 4, ch = id & 15; *(LAS v4u*)(WS_ + p * 272 + ch * 16) = gw_[i]; }
#pragma unroll
        for (int i = 0; i < 3; ++i) { const int id = tid + 512 * i, q = id & 127, cc = id >> 7; const int c0 = g * 96 + cc * 8;
            const v4u r = gv_[i];
            const float mean = STAT[2 * q], rstd = STAT[2 * q + 1];
            const f32x4 g0 = *(const LAS f32x4*)(LNG + c0), g1 = *(const LAS f32x4*)(LNG + c0 + 4), b0 = *(const LAS f32x4*)(LNB + c0), b1 = *(const LAS f32x4*)(LNB + c0 + 4);
            LAS unsigned short* vt = (LAS unsigned short*)(VT + (cc * 8) * 272 + q * 2);
            vt[0 * 136] = (unsigned short)f2bf((bflo(r.x) - mean) * rstd * g0.x + b0.x); vt[1 * 136] = (unsigned short)f2bf((bfhi(r.x) - mean) * rstd * g0.y + b0.y);
            vt[2 * 136] = (unsigned short)f2bf((bflo(r.y) - mean) * rstd * g0.z + b0.z); vt[3 * 136] = (unsigned short)f2bf((bfhi(r.y) - mean) * rstd * g0.w + b0.w);
            vt[4 * 136] = (unsigned short)f2bf((bflo(r.z) - mean) * rstd * g1.x + b1.x); vt[5 * 136] = (unsigned short)f2bf((bfhi(r.z) - mean) * rstd * g1.y + b1.y);
            vt[6 * 136] = (unsigned short)f2bf((bflo(r.w) - mean) * rstd * g1.z + b1.z); vt[7 * 136] = (unsigned short)f2bf((bfhi(r.w) - mean) * rstd * g1.w + b1.w); }
        LBAR();
        v2u uu[6];
#pragma unroll
        for (int ct = 0; ct < 6; ++ct) uu[ct] = gu_[ct];
        if (g < 7) MIX_ISSUE(g + 1);
        const int p = 16 * w + r16; float bias = bias_[0];
#pragma unroll
        for (int k = 1; k < 8; ++k) bias = (g == k) ? bias_[k] : bias;
        bf16* opb = CAT + (size_t)t0 * DM + g * 96; const unsigned opo = (unsigned)(p * DM + 4 * quad) * 2u;
        f32x4 acc[6];
#pragma unroll
        for (int ct = 0; ct < 6; ++ct) acc[ct] = (f32x4){0.f, 0.f, 0.f, 0.f};
#pragma unroll
        for (int ks = 0; ks < 4; ++ks) { const bf16x8 wf = lds_frag(WS_ + (16 * w + r16) * 272 + ks * 64 + quad * 16);
#pragma unroll
            for (int ct = 0; ct < 6; ++ct) acc[ct] = mfma16(lds_frag(VT + (16 * ct + r16) * 272 + ks * 64 + quad * 16), wf, acc[ct]); }
#pragma unroll
        for (int ct = 0; ct < 6; ct += 2) { const v2u u = uu[ct], u2 = uu[ct + 1];
            gst8x2(opb, opo + 32u * ct, pk4(bflo(u.x) * (acc[ct][0] + bias), bfhi(u.x) * (acc[ct][1] + bias), bflo(u.y) * (acc[ct][2] + bias), bfhi(u.y) * (acc[ct][3] + bias)),
                   pk4(bflo(u2.x) * (acc[ct + 1][0] + bias), bfhi(u2.x) * (acc[ct + 1][1] + bias), bflo(u2.y) * (acc[ct + 1][2] + bias), bfhi(u2.y) * (acc[ct + 1][3] + bias)), quad); }
        LBAR();
    }
#undef MIX_ISSUE
    AttnRegs AR; attn_issue(AR, tid, H0 + 2 * MIXW, NINA, b, 0, t0, (const bf16*)(ws + WS_MEMK), (const bf16*)(ws + WS_MEMVT));
    for (int hh = 0; hh < 4; ++hh) {
        attn_commit(F, AR); LBAR();
        if (hh < 3) attn_issue(AR, tid, H0 + 2 * MIXW + (hh + 1) * 64, NINA, b, hh + 1, t0, (const bf16*)(ws + WS_MEMK), (const bf16*)(ws + WS_MEMVT));
        attn_compute(F, t0, CAT, MIXW + hh * 64); LBAR(); }
}

__device__ __forceinline__ void ln_rows(Frame& F, const float* Z, const float* g, const float* b, bf16* X) {
    const int gw = F.vcu * NWAVES + F.wave, NGW = F.G * NWAVES;
    f32x4 gv[4], bv[4];
#pragma unroll
    for (int j = 0; j < 4; ++j) { gv[j] = ((const GAS f32x4*)g)[F.lane + 64 * j]; bv[j] = ((const GAS f32x4*)b)[F.lane + 64 * j]; }
    for (int m = gw; m < NTOK; m += NGW) { const GAS f32x4* zr = (const GAS f32x4*)(Z + (size_t)m * DM) + F.lane;
        f32x4 v[4]; float s = 0.f;
#pragma unroll
        for (int j = 0; j < 4; ++j) { v[j] = zr[64 * j]; s += (v[j].x + v[j].y) + (v[j].z + v[j].w); }
        const float mean = wave_sum(s) * (1.f / DM); float s2 = 0.f;
#pragma unroll
        for (int j = 0; j < 4; ++j) { v[j] = v[j] - mean; s2 += (v[j].x * v[j].x + v[j].y * v[j].y) + (v[j].z * v[j].z + v[j].w * v[j].w); }
        const float rstd = 1.f / sqrtf(wave_sum(s2) * (1.f / DM) + LN_EPS);
        GAS unsigned long long* o8 = (GAS unsigned long long*)(X + (size_t)m * DM) + F.lane;
#pragma unroll
        for (int j = 0; j < 4; ++j) { const f32x4 y = v[j] * rstd * gv[j] + bv[j]; o8[64 * j] = pk4(y.x, y.y, y.z, y.w); } }
}

struct KvRegs { v4u k[4], v[6]; };
__device__ __forceinline__ void kv_issue(KvRegs& R, int tid, const bf16* H1, int unit) {
    const int h = unit & 3, t0 = (unit >> 2) * 128;
#pragma unroll
    for (int i = 0; i < 2; ++i) { const int id = tid + 512 * i; if (id < 768) { const int j = id & 127, gq = id >> 7;
        const unsigned ko = (unsigned)(j * NINB + gq * 8) * 2u; const bf16* kbase = H1 + (size_t)t0 * NINB + QKW + h * 96; R.k[2 * i] = gld16(kbase, ko); R.k[2 * i + 1] = gld16(kbase, ko + 96u); } }
#pragma unroll
    for (int i = 0; i < 6; ++i) { const int id = tid + 512 * i, j = id & 127, ec = id >> 7; R.v[i] = gld16(H1 + (size_t)t0 * NINB + 2 * QKW + h * 192, (unsigned)(j * NINB + ec * 8) * 2u); }
}
__device__ __forceinline__ void ret_kv_phase(Frame& F, const Args& A) {
    unsigned char* ws = A.ws;
    const bf16* H1 = (const bf16*)(ws + WS_H1); bf16* KVS = (bf16*)A.out; const float* prm = (const float*)(ws + WS_PRM);
    const int w = F.wave;
    LAS unsigned char* KF = F.lds + RING_OFF; LAS unsigned char* KB = KF + 96 * 272; LAS unsigned char* VT = KB + 96 * 272;
    int unit = F.vcu; if (unit >= 1024) return;
    KvRegs R; kv_issue(R, F.tid, H1, unit);
    for (; unit < 1024; unit += F.G) {
        const int h = unit & 3; const float l2f = prm[h], l2b = prm[4 + h];
        int tid = F.tid; asm volatile("" : "+v"(tid));
#pragma unroll
        for (int i = 0; i < 2; ++i) { const int id = tid + 512 * i; if (id < 768) { const int j = id & 127, gq = id >> 7; const v4u r1 = R.k[2 * i], r2 = R.k[2 * i + 1];
            const float sf = __builtin_amdgcn_exp2f((float)(128 - j) * l2f), sb = __builtin_amdgcn_exp2f((float)(j + 1) * l2b);
            const float t1[8] = {bflo(r1.x), bfhi(r1.x), bflo(r1.y), bfhi(r1.y), bflo(r1.z), bfhi(r1.z), bflo(r1.w), bfhi(r1.w)};
            const float t2[8] = {bflo(r2.x), bfhi(r2.x), bflo(r2.y), bfhi(r2.y), bflo(r2.z), bfhi(r2.z), bflo(r2.w), bfhi(r2.w)};
            LAS unsigned short* kf = (LAS unsigned short*)(KF + (gq * 8) * 272 + j * 2); LAS unsigned short* kb = (LAS unsigned short*)(KB + (gq * 8) * 272 + j * 2);
#pragma unroll
            for (int e = 0; e < 8; ++e) { const float o1 = t1[e], o2 = t2[e];
                kf[e * 136] = (unsigned short)f2bf(o1 * sf); kf[(48 + e) * 136] = (unsigned short)f2bf(o2 * sf);
                kb[e * 136] = (unsigned short)f2bf(o1 * sb); kb[(48 + e) * 136] = (unsigned short)f2bf(o2 * sb); } } }
#pragma unroll
        for (int i = 0; i < 6; ++i) { const int id = tid + 512 * i, j = id & 127, ec = id >> 7; const v4u r = R.v[i];
            LAS unsigned short* vt = (LAS unsigned short*)(VT + (ec * 8) * 272 + j * 2);
            vt[0 * 136] = (unsigned short)(r.x & 0xffffu); vt[1 * 136] = (unsigned short)(r.x >> 16); vt[2 * 136] = (unsigned short)(r.y & 0xffffu); vt[3 * 136] = (unsigned short)(r.y >> 16);
            vt[4 * 136] = (unsigned short)(r.z & 0xffffu); vt[5 * 136] = (unsigned short)(r.z >> 16); vt[6 * 136] = (unsigned short)(r.w & 0xffffu); vt[7 * 136] = (unsigned short)(r.w >> 16); }
        LBAR();
        asm volatile("" : "+v"(tid));
        if (unit + F.G < 1024) kv_issue(R, tid, H1, unit + F.G);
        const int lane = tid & 63, r16 = lane & 15, quad = lane >> 4;
        const int dir = w & 1, eg = w >> 1; const LAS unsigned char* KX = dir ? KB : KF;
        f32x4 acc[3][6];
#pragma unroll
        for (int et = 0; et < 3; ++et)
#pragma unroll
            for (int dt = 0; dt < 6; ++dt) acc[et][dt] = (f32x4){0.f, 0.f, 0.f, 0.f};
#pragma unroll
        for (int ks = 0; ks < 4; ++ks) { bf16x8 kf[6];
#pragma unroll
            for (int dt = 0; dt < 6; ++dt) kf[dt] = lds_frag(KX + (16 * dt + r16) * 272 + ks * 64 + quad * 16);
#pragma unroll
            for (int et = 0; et < 3; ++et) { const bf16x8 vf = lds_frag(VT + (16 * (3 * eg + et) + r16) * 272 + ks * 64 + quad * 16);
#pragma unroll
                for (int dt = 0; dt < 6; ++dt) acc[et][dt] = mfma16(kf[dt], vf, acc[et][dt]); } }
        bf16* out = KVS + ((size_t)unit * 2 + dir) * (192 * 96);
#pragma unroll
        for (int et = 0; et < 3; ++et) { const int e = 16 * (3 * eg + et) + r16;
#pragma unroll
            for (int dt = 0; dt < 6; dt += 2) gst8x2(out, (unsigned)(e * 96 + 16 * dt + 4 * quad) * 2u, pk4(acc[et][dt][0], acc[et][dt][1], acc[et][dt][2], acc[et][dt][3]), pk4(acc[et][dt + 1][0], acc[et][dt + 1][1], acc[et][dt + 1][2], acc[et][dt + 1][3]), quad); }
        LBAR();
    }
}

__device__ __forceinline__ void ret_scan(Frame& F, const Args& A) {
    bf16* KVS = (bf16*)A.out; const float* prm = (const float*)(A.ws + WS_PRM);
    const int gt = F.vcu * (NWAVES * 64) + F.tid, NGT = F.G * NWAVES * 64;
    for (int idx = gt; idx < 32 * 2304; idx += NGT) { const int combo = idx / 2304, v = idx - combo * 2304, b = combo >> 3, h = (combo >> 1) & 3, dir = combo & 1;
        const float decay = __builtin_amdgcn_exp2f(128.0f * prm[dir * 4 + h]);
        float S[8];
#pragma unroll
        for (int j = 0; j < 8; ++j) S[j] = 0.f;
#define SCAN_PTR(st) ((GAS v4u*)(KVS + ((size_t)(((b * 64 + (dir ? 63 - (st) : (st))) * 4 + h) * 2 + dir)) * (192 * 96) + (size_t)v * 8))
#define SCAN_LOAD(r, st0) do { _Pragma("unroll") for (int u = 0; u < 4; ++u) r[u] = __builtin_nontemporal_load(SCAN_PTR((st0) + u)); } while (0)
#define SCAN_STEP(r, st0) do { _Pragma("unroll") for (int u = 0; u < 4; ++u) { const float t[8] = {bflo(r[u].x), bfhi(r[u].x), bflo(r[u].y), bfhi(r[u].y), bflo(r[u].z), bfhi(r[u].z), bflo(r[u].w), bfhi(r[u].w)}; \
            v4u o; o.x = pk2(S[0], S[1]); o.y = pk2(S[2], S[3]); o.z = pk2(S[4], S[5]); o.w = pk2(S[6], S[7]); *SCAN_PTR((st0) + u) = o; \
            _Pragma("unroll") for (int j = 0; j < 8; ++j) S[j] = S[j] * decay + t[j]; } } while (0)
        v4u ra[4], rb[4]; SCAN_LOAD(ra, 0);
        for (int step = 0; step < 64; step += 8) {
            SCAN_LOAD(rb, step + 4);
            SCAN_STEP(ra, step);
            if (step + 8 < 64) SCAN_LOAD(ra, step + 8);
            SCAN_STEP(rb, step + 4); }
#undef SCAN_PTR
#undef SCAN_LOAD
#undef SCAN_STEP
    }
}

struct RetRegs { v4u qk[6]; };
__device__ __forceinline__ void ret_issue(RetRegs& R, int tid, const bf16* H1, int unit) {
    const int h = unit & 3, t0 = (unit >> 2) * 128;
#pragma unroll
    for (int i = 0; i < 3; ++i) { const int id = tid + 512 * i, isk = id >= 768, id2 = isk ? id - 768 : id, row = id2 / 6, gq = id2 - row * 6;
        const unsigned qo = (unsigned)(row * NINB + (isk ? QKW : 0) + gq * 8) * 2u; const bf16* qbase = H1 + (size_t)t0 * NINB + h * 96; R.qk[2 * i] = gld16(qbase, qo); R.qk[2 * i + 1] = gld16(qbase, qo + 96u); }
}
__device__ __forceinline__ void ret_out_phase(Frame& F, const Args& A) {
    unsigned char* ws = A.ws;
    const bf16* H1 = (const bf16*)(ws + WS_H1); const bf16* KVS = (const bf16*)A.out; bf16* CAT = (bf16*)(ws + WS_CAT1);
    const float* prm = (const float*)(ws + WS_PRM); const float* gng = inp(F, 11); const float* gnb = inp(F, 12);
    const int w = F.wave;
    LAS unsigned char* QS = F.lds + RING_OFF; LAS unsigned char* VT = QS + 128 * 208; LAS unsigned char* XS = VT + 192 * 272;
    LAS float* GNG = (LAS float*)(XS + 192 * 208); LAS float* GNB = GNG + MIXW;
    static_assert(128 * 208 + 192 * 272 + 192 * 208 + 2 * MIXW * 4 <= RING_BYTES, "P11 LDS map");
    for (int i = F.tid; i < MIXW; i += NWAVES * 64) { GNG[i] = gld4(gng, (unsigned)i * 4u); GNB[i] = gld4(gnb, (unsigned)i * 4u); }
    int unit = F.vcu; if (unit >= 1024) return;
    RetRegs RR; ret_issue(RR, F.tid, H1, unit);
#define REPIN(v) do { v = F.tid; asm volatile("" : "+v"(v)); } while (0)
    for (; unit < 1024; unit += F.G) {
        const int h = unit & 3, bn = unit >> 2, t0 = bn * 128; const float l2f = prm[h], l2b = prm[4 + h];
        int tid; REPIN(tid); int lane = tid & 63, r16 = lane & 15, quad = lane >> 4;
#pragma unroll
        for (int i = 0; i < 3; ++i) { const int id = tid + 512 * i, isk = id >= 768, id2 = isk ? id - 768 : id, row = id2 / 6, gq = id2 - row * 6;
            LAS unsigned char* dst = (isk ? XS : QS) + row * 208 + gq * 16; *(LAS v4u*)dst = RR.qk[2 * i]; *(LAS v4u*)(dst + 96) = RR.qk[2 * i + 1]; }
        v4u vv[6];
#pragma unroll
        for (int i = 0; i < 6; ++i) { const int id = tid + 512 * i, j = id & 127, ec = id >> 7; vv[i] = gld16(H1 + (size_t)t0 * NINB + 2 * QKW + h * 192, (unsigned)(j * NINB + ec * 8) * 2u); }
        const bf16* SF = KVS + ((size_t)unit * 2 + 0) * (192 * 96); const bf16* SB = KVS + ((size_t)unit * 2 + 1) * (192 * 96);
        REPIN(tid);
        v4u st[5];
#pragma unroll
        for (int i = 0; i < 5; ++i) { const int id = tid + 512 * i; if (id < 2304) st[i] = gld16(SF, (unsigned)id * 16u); }
        LBAR();
        const int ii = 16 * w + r16;
        bf16x8 qf[3], pf[4];
        { f32x4 sc_[8];
#pragma unroll
          for (int jt = 0; jt < 8; ++jt) sc_[jt] = (f32x4){0.f, 0.f, 0.f, 0.f};
#pragma unroll
          for (int ks = 0; ks < 3; ++ks) { qf[ks] = lds_frag(QS + ii * 208 + ks * 64 + quad * 16);
#pragma unroll
              for (int jt = 0; jt < 8; ++jt) sc_[jt] = mfma16(lds_frag(XS + (16 * jt + r16) * 208 + ks * 64 + quad * 16), qf[ks], sc_[jt]); }
          int iv = ii - 4 * quad; asm volatile("" : "+v"(iv));
#pragma unroll
          for (int jt = 0; jt < 8; ++jt)
#pragma unroll
              for (int r = 0; r < 4; ++r) { const int df = iv - (16 * jt + r); const float m = df >= 0 ? __builtin_amdgcn_exp2f((float)df * l2f) : __builtin_amdgcn_exp2f((float)(-df) * l2b); sc_[jt][r] *= m; }
#pragma unroll
          for (int st4 = 0; st4 < 4; ++st4) pf[st4] = pack_frag(sc_[2 * st4], sc_[2 * st4 + 1]); }
        REPIN(tid);
#pragma unroll
        for (int i = 0; i < 6; ++i) { const int id = tid + 512 * i, j = id & 127, ec = id >> 7; const v4u r = vv[i];
            LAS unsigned short* vt = (LAS unsigned short*)(VT + (ec * 8) * 272 + j * 2);
            vt[0 * 136] = (unsigned short)(r.x & 0xffffu); vt[1 * 136] = (unsigned short)(r.x >> 16); vt[2 * 136] = (unsigned short)(r.y & 0xffffu); vt[3 * 136] = (unsigned short)(r.y >> 16);
            vt[4 * 136] = (unsigned short)(r.z & 0xffffu); vt[5 * 136] = (unsigned short)(r.z >> 16); vt[6 * 136] = (unsigned short)(r.w & 0xffffu); vt[7 * 136] = (unsigned short)(r.w >> 16); }
        LBAR();
        REPIN(tid); lane = tid & 63; r16 = lane & 15; quad = lane >> 4;
#pragma unroll
        for (int i = 0; i < 5; ++i) { const int id = tid + 512 * i; if (id < 2304) { const int e = id / 12, ch = id - e * 12; *(LAS v4u*)(XS + e * 208 + ch * 16) = st[i]; } }
#pragma unroll
        for (int i = 0; i < 5; ++i) { const int id = tid + 512 * i; if (id < 2304) st[i] = gld16(SB, (unsigned)id * 16u); }
        v2u gr[12];
#pragma unroll
        for (int et = 0; et < 12; ++et) gr[et] = gld8(H1 + (size_t)t0 * NINB + 2 * QKW + MIXW + h * 192, (unsigned)(ii * NINB + 4 * quad + 16 * et) * 2u);
        f32x4 o[12];
#pragma unroll
        for (int et = 0; et < 12; ++et) o[et] = (f32x4){0.f, 0.f, 0.f, 0.f};
#pragma unroll
        for (int st4 = 0; st4 < 4; ++st4)
#pragma unroll
            for (int et = 0; et < 12; ++et) { const LAS unsigned char* vp = VT + (16 * et + r16) * 272 + (32 * st4 + 4 * quad) * 2; o[et] = mfma16(lds_frag_split(vp, vp + 32), pf[st4], o[et]); }
        LBAR();
        { const float sc = __builtin_amdgcn_exp2f((float)ii * l2f);
#pragma unroll
          for (int ks = 0; ks < 3; ++ks) { const bf16x8 q2 = scale_frag(qf[ks], sc);
#pragma unroll
              for (int et = 0; et < 12; ++et) o[et] = mfma16(lds_frag(XS + (16 * et + r16) * 208 + ks * 64 + quad * 16), q2, o[et]); } }
        LBAR();
        REPIN(tid); lane = tid & 63; r16 = lane & 15; quad = lane >> 4;
#pragma unroll
        for (int i = 0; i < 5; ++i) { const int id = tid + 512 * i; if (id < 2304) { const int e = id / 12, ch = id - e * 12; *(LAS v4u*)(XS + e * 208 + ch * 16) = st[i]; } }
        AttnRegs AR; attn_issue(AR, tid, H1 + 2 * QKW + 2 * MIXW + h * 64, NINB, t0 / SEQ, h, t0, (const bf16*)(ws + WS_MEMK), (const bf16*)(ws + WS_MEMVT));
        LBAR();
        { const float sc = __builtin_amdgcn_exp2f((float)(127 - ii) * l2b);
#pragma unroll
          for (int ks = 0; ks < 3; ++ks) { const bf16x8 q2 = scale_frag(qf[ks], sc);
#pragma unroll
              for (int et = 0; et < 12; ++et) o[et] = mfma16(lds_frag(XS + (16 * et + r16) * 208 + ks * 64 + quad * 16), q2, o[et]); } }
        float sm = 0.f;
#pragma unroll
        for (int et = 0; et < 12; ++et) sm += (o[et][0] + o[et][1]) + (o[et][2] + o[et][3]);
        sm = pg8::xsum32(pg8::xsum16(sm));
        const float mean = sm * (1.0f / 192.0f); float q = 0.f;
#pragma unroll
        for (int et = 0; et < 12; ++et) { o[et] = o[et] - mean; q += (o[et][0] * o[et][0] + o[et][1] * o[et][1]) + (o[et][2] * o[et][2] + o[et][3] * o[et][3]); }
        q = pg8::xsum32(pg8::xsum16(q));
        const float rstd = 1.0f / sqrtf(q * (1.0f / 192.0f) + LN_EPS);
        bf16* opb = CAT + (size_t)t0 * DM + h * 192; const unsigned opo = (unsigned)(ii * DM + 4 * quad) * 2u;
#pragma unroll
        for (int et = 0; et < 12; et += 2) { unsigned long long pv[2];
#pragma unroll
            for (int k = 0; k < 2; ++k) { const int e2 = et + k; const f32x4 gg = *(const LAS f32x4*)(GNG + h * 192 + 4 * quad + 16 * e2), gb = *(const LAS f32x4*)(GNB + h * 192 + 4 * quad + 16 * e2);
                const f32x4 y = o[e2] * rstd * gg + gb;
                pv[k] = pk4(silu_f(bflo(gr[e2].x)) * y[0], silu_f(bfhi(gr[e2].x)) * y[1], silu_f(bflo(gr[e2].y)) * y[2], silu_f(bfhi(gr[e2].y)) * y[3]); }
            gst8x2(opb, opo + 32u * et, pv[0], pv[1], quad); }
        LBAR();
        attn_commit(F, AR);
        REPIN(tid);
        if (unit + F.G < 1024) ret_issue(RR, tid, H1, unit + F.G);
        LBAR();
        attn_compute(F, t0, CAT, MIXW + h * 64);
        LBAR();
    }
#undef REPIN
}

__device__ __forceinline__ void ln_router(Frame& F, const Args& A, const bf16* Zb, const float* g, const float* b, unsigned char* XQ) {
    const int gw = F.vcu * NWAVES + F.wave, NGW = F.G * NWAVES;
    const float* wr = inp(F, 19); const float* br = inp(F, 20);
    LAS float* WT = (LAS float*)(F.lds + RING_OFF);
    for (int i = F.tid; i < 8192; i += NWAVES * 64) WT[(i & 7) * 1024 + (i >> 3)] = wr[i];
    __syncthreads();
    int* topi = (int*)(A.ws + WS_TOPI); float* gate = (float*)(A.ws + WS_GATE); unsigned* hist = (unsigned*)(F.ctl + CW_HIST);
    f32x4 gv[4], bv[4];
#pragma unroll
    for (int j = 0; j < 4; ++j) { gv[j] = ((const GAS f32x4*)g)[F.lane + 64 * j]; bv[j] = ((const GAS f32x4*)b)[F.lane + 64 * j]; }
    float brv[8];
#pragma unroll
    for (int e = 0; e < 8; ++e) brv[e] = br[e];
    constexpr int PD = 4;
    v2u rawq[PD][4];
#pragma unroll
    for (int d = 0; d < PD; ++d) if (gw + d * NGW < NTOK) {
#pragma unroll
        for (int j = 0; j < 4; ++j) rawq[d][j] = __builtin_nontemporal_load((const GAS v2u*)(Zb + (size_t)(gw + d * NGW) * DM) + F.lane + 64 * j); }
    for (int mb = gw; mb < NTOK; mb += PD * NGW) {
#pragma unroll
      for (int d = 0; d < PD; ++d) { const int m = mb + d * NGW; if (m >= NTOK) break; v2u (&raw)[4] = rawq[d];
        f32x4 v[4]; float s = 0.f;
#pragma unroll
        for (int j = 0; j < 4; ++j) { const v2u q = raw[j]; v[j] = (f32x4){bflo(q.x), bfhi(q.x), bflo(q.y), bfhi(q.y)}; s += (v[j].x + v[j].y) + (v[j].z + v[j].w); }
        if (m + PD * NGW < NTOK) {
#pragma unroll
            for (int j = 0; j < 4; ++j) raw[j] = __builtin_nontemporal_load((const GAS v2u*)(Zb + (size_t)(m + PD * NGW) * DM) + F.lane + 64 * j); }
        const float mean = wave_sum(s) * (1.f / DM); float s2 = 0.f;
#pragma unroll
        for (int j = 0; j < 4; ++j) { v[j] = v[j] - mean; s2 += (v[j].x * v[j].x + v[j].y * v[j].y) + (v[j].z * v[j].z + v[j].w * v[j].w); }
        const float rstd = 1.f / sqrtf(wave_sum(s2) * (1.f / DM) + LN_EPS);
#pragma unroll
        for (int j = 0; j < 4; ++j) { v[j] = v[j] * rstd * gv[j] + bv[j];
            ((GAS unsigned*)(XQ + (size_t)m * DM))[F.lane + 64 * j] = pk_i8x4(v[j].x * ZQ_SCALE, v[j].y * ZQ_SCALE, v[j].z * ZQ_SCALE, v[j].w * ZQ_SCALE); }
        float pe_[8];
#pragma unroll
        for (int e = 0; e < 8; ++e) { float p = 0.f;
#pragma unroll
            for (int j = 0; j < 4; ++j) { const f32x4 wv = *(const LAS f32x4*)(WT + e * 1024 + 4 * F.lane + 256 * j); p += (v[j].x * wv.x + v[j].y * wv.y) + (v[j].z * wv.z + v[j].w * wv.w); }
            pe_[e] = p; }
        const bool h3 = (F.lane & 8) != 0;
        float q4[4], q2[2], q1;
#pragma unroll
        for (int k = 0; k < 4; ++k) { const auto r = __builtin_amdgcn_permlane32_swap(__float_as_uint(pe_[k]), __float_as_uint(pe_[k + 4]), false, false); q4[k] = __uint_as_float(r[0]) + __uint_as_float(r[1]); }
#pragma unroll
        for (int k = 0; k < 2; ++k) { const auto r = __builtin_amdgcn_permlane16_swap(__float_as_uint(q4[k]), __float_as_uint(q4[k + 2]), false, false); q2[k] = __uint_as_float(r[0]) + __uint_as_float(r[1]); }
        { const float snd = h3 ? q2[0] : q2[1], kp = h3 ? q2[1] : q2[0]; q1 = kp + pg8::dpp_f<pg8::DPP_RM>(snd); }
        q1 = pg8::sum8(q1);
        float lg[8];
#pragma unroll
        for (int e = 0; e < 8; ++e) lg[e] = __uint_as_float((unsigned)__builtin_amdgcn_readlane((int)__float_as_uint(q1), 8 * e)) + brv[e];
        int e0 = 0; float l0 = lg[0];
#pragma unroll
        for (int e = 1; e < 8; ++e) if (lg[e] > l0) { l0 = lg[e]; e0 = e; }
        int e1 = -1; float l1 = -3.0e38f;
#pragma unroll
        for (int e = 0; e < 8; ++e) if (e != e0 && lg[e] > l1) { l1 = lg[e]; e1 = e; }
        if (F.lane == 0) { const float w0 = 1.0f / (1.0f + __builtin_amdgcn_exp2f((l1 - l0) * 1.44269504089f));
            topi[2 * m] = e0; topi[2 * m + 1] = e1; gate[2 * m] = w0; gate[2 * m + 1] = 1.0f - w0;
            atomicAdd(hist + (m >> 7) * 8 + e0, 1u); atomicAdd(hist + (m >> 7) * 8 + e1, 1u); } } }
    __syncthreads();
}

__device__ __forceinline__ void route_positions(Frame& F, const Args& A) {
    LAS int* bh = (LAS int*)(F.lds + RING_OFF); LAS int* pre = bh + 2048; LAS int* cnt = pre + 2048;
    const unsigned* hist = (const unsigned*)(F.ctl + CW_HIST);
    for (int i = F.tid; i < 2048; i += NWAVES * 64) bh[i] = (int)hist[i];
    __syncthreads();
    if (F.tid < 8) { int run = 0; for (int blk = 0; blk < 256; ++blk) { pre[blk * 8 + F.tid] = run; run += bh[blk * 8 + F.tid]; } cnt[F.tid] = run; }
    __syncthreads();
    if (F.tid == 0) { int ps = 0; for (int e = 0; e < 8; ++e) { cnt[8 + e] = ps; ps += ((cnt[e] + 255) >> 8) << 8; } cnt[16] = ps >> 8; }
    __syncthreads();
    if (F.vcu == 0) { int* pe = (int*)(F.ctl + CW_PE);
        for (int p = F.tid; p < 272; p += NWAVES * 64) { const int row = p * 256; int e = 0;
#pragma unroll
            for (int ee = 1; ee < 8; ++ee) if (row >= cnt[8 + ee]) e = ee;
            pe[p] = e; }
        if (F.tid == 0) *(int*)(F.ctl + CW_NP) = cnt[16]; }
    const int* topi = (const int*)(A.ws + WS_TOPI); int* dest = (int*)(A.ws + WS_DEST); int* rowtok = (int*)(A.ws + WS_ROWTOK);
    if (F.wave == 0) for (int blk = F.vcu; blk < 256; blk += F.G) { int run[8];
#pragma unroll
        for (int e = 0; e < 8; ++e) run[e] = 0;
        const unsigned long long lt = (1ull << F.lane) - 1ull;
        for (int ps = 0; ps < 4; ++ps) { const int a = blk * 256 + ps * 64 + F.lane; const int e = topi[a]; int rank = 0;
#pragma unroll
            for (int ee = 0; ee < 8; ++ee) { const unsigned long long mk = __ballot(e == ee); if (e == ee) rank = run[ee] + __popcll(mk & lt); run[ee] += __popcll(mk); }
            const int d = cnt[8 + e] + pre[blk * 8 + e] + rank; dest[a] = d; rowtok[d] = a >> 1; } }
    __syncthreads();
}

__device__ __forceinline__ void final_rows(Frame& F, const Args& A) {
    const int gw = F.vcu * NWAVES + F.wave, NGW = F.G * NWAVES;
    const bf16* Z3b = (const bf16*)(A.ws + WS_X3); const bf16* YR = (const bf16*)(A.ws + WS_YR); const int* dest = (const int*)(A.ws + WS_DEST); const float* gate = (const float*)(A.ws + WS_GATE);
    const float* g3 = inp(F, 14) + 2 * DM; const float* b3 = inp(F, 15) + 2 * DM; const float* g = inp(F, 14) + 3 * DM; const float* b = inp(F, 15) + 3 * DM; float* out = A.out;
    f32x4 gv[4], bv[4], g3v[4], b3v[4];
#pragma unroll
    for (int j = 0; j < 4; ++j) { gv[j] = ((const GAS f32x4*)g)[F.lane + 64 * j]; bv[j] = ((const GAS f32x4*)b)[F.lane + 64 * j]; g3v[j] = ((const GAS f32x4*)g3)[F.lane + 64 * j] * ALPHA; b3v[j] = ((const GAS f32x4*)b3)[F.lane + 64 * j] * ALPHA; }
    int dA0 = 0, dA1 = 0, dB0 = 0, dB1 = 0; float wA0 = 0.f, wA1 = 0.f, wB0 = 0.f, wB1 = 0.f; v2u an[4], pn[4], qn[4];
    if (gw < NTOK) { dA0 = dest[2 * gw]; dA1 = dest[2 * gw + 1]; wA0 = gate[2 * gw]; wA1 = gate[2 * gw + 1];
#pragma unroll
        for (int j = 0; j < 4; ++j) { an[j] = __builtin_nontemporal_load((const GAS v2u*)(Z3b + (size_t)gw * DM) + F.lane + 64 * j); pn[j] = __builtin_nontemporal_load((const GAS v2u*)(YR + (size_t)dA0 * DM) + F.lane + 64 * j); qn[j] = __builtin_nontemporal_load((const GAS v2u*)(YR + (size_t)dA1 * DM) + F.lane + 64 * j); } }
    if (gw + NGW < NTOK) { dB0 = dest[2 * (gw + NGW)]; dB1 = dest[2 * (gw + NGW) + 1]; wB0 = gate[2 * (gw + NGW)]; wB1 = gate[2 * (gw + NGW) + 1]; }
    const float* PARTY = (const float*)(A.ws + WS_PARTY); constexpr int TAIL0 = 2 * PASS_PANELS * 256;
    for (int m = gw; m < NTOK; m += NGW) { const float w0 = wA0, w1 = wA1; const int dc0 = dA0, dc1 = dA1;
        f32x4 v[4]; v2u p[4], q[4]; float s = 0.f;
#pragma unroll
        for (int j = 0; j < 4; ++j) { const v2u a = an[j]; p[j] = pn[j]; q[j] = qn[j]; v[j] = (f32x4){bflo(a.x), bfhi(a.x), bflo(a.y), bfhi(a.y)}; s += (v[j].x + v[j].y) + (v[j].z + v[j].w); }
        if (m + NGW < NTOK) {
#pragma unroll
            for (int j = 0; j < 4; ++j) { an[j] = __builtin_nontemporal_load((const GAS v2u*)(Z3b + (size_t)(m + NGW) * DM) + F.lane + 64 * j); pn[j] = __builtin_nontemporal_load((const GAS v2u*)(YR + (size_t)dB0 * DM) + F.lane + 64 * j); qn[j] = __builtin_nontemporal_load((const GAS v2u*)(YR + (size_t)dB1 * DM) + F.lane + 64 * j); } }
        wA0 = wB0; wA1 = wB1; dA0 = dB0; dA1 = dB1;
        if (m + 2 * NGW < NTOK) { dB0 = dest[2 * (m + 2 * NGW)]; dB1 = dest[2 * (m + 2 * NGW) + 1]; wB0 = gate[2 * (m + 2 * NGW)]; wB1 = gate[2 * (m + 2 * NGW) + 1]; }
        float mean = wave_sum(s) * (1.f / DM); float s2 = 0.f;
#pragma unroll
        for (int j = 0; j < 4; ++j) { v[j] = v[j] - mean; s2 += (v[j].x * v[j].x + v[j].y * v[j].y) + (v[j].z * v[j].z + v[j].w * v[j].w); }
        float rstd = 1.f / sqrtf(wave_sum(s2) * (1.f / DM) + LN_EPS); s = 0.f;
#pragma unroll
        for (int j = 0; j < 4; ++j) { f32x4 f0 = (f32x4){bflo(p[j].x), bfhi(p[j].x), bflo(p[j].y), bfhi(p[j].y)}, f1 = (f32x4){bflo(q[j].x), bfhi(q[j].x), bflo(q[j].y), bfhi(q[j].y)};
            if (dc0 >= TAIL0) { f32x4 t[7];
#pragma unroll
                for (int ks = 0; ks < 7; ++ks) t[ks] = ((const GAS f32x4*)(PARTY + ((size_t)ks * 2048 + (dc0 - TAIL0)) * DM))[F.lane + 64 * j];
                f0 = ((t[0] + t[1]) + (t[2] + t[3])) + ((t[4] + t[5]) + t[6]); }
            if (dc1 >= TAIL0) { f32x4 t[7];
#pragma unroll
                for (int ks = 0; ks < 7; ++ks) t[ks] = ((const GAS f32x4*)(PARTY + ((size_t)ks * 2048 + (dc1 - TAIL0)) * DM))[F.lane + 64 * j];
                f1 = ((t[0] + t[1]) + (t[2] + t[3])) + ((t[4] + t[5]) + t[6]); }
            v[j] = v[j] * rstd * g3v[j] + b3v[j] + (f0 * w0 + f1 * w1); s += (v[j].x + v[j].y) + (v[j].z + v[j].w); }
        mean = wave_sum(s) * (1.f / DM); s2 = 0.f;
#pragma unroll
        for (int j = 0; j < 4; ++j) { v[j] = v[j] - mean; s2 += (v[j].x * v[j].x + v[j].y * v[j].y) + (v[j].z * v[j].z + v[j].w * v[j].w); }
        rstd = 1.f / sqrtf(wave_sum(s2) * (1.f / DM) + LN_EPS);
        GAS f32x4* o = (GAS f32x4*)(out + (size_t)m * DM) + F.lane;
#pragma unroll
        for (int j = 0; j < 4; ++j) __builtin_nontemporal_store(v[j] * rstd * gv[j] + bv[j], o + 64 * j); }
}

constexpr int N_PHASES = 17;
__global__ void __launch_bounds__(NWAVES * 64, 2) hyb_fwd(Args args) {
    extern __shared__ __attribute__((aligned(16))) unsigned char lds[];
    Frame F;
    F.lds = (LAS unsigned char*)lds;
    F.MISC = (volatile LAS unsigned*)(F.lds + MISC_OFF);
    F.tid = threadIdx.x; F.lane = F.tid & 63; F.wave = __builtin_amdgcn_readfirstlane(F.tid >> 6);
    F.G = gridDim.x; { const int bx = blockIdx.x; F.vcu = (F.G % 8 == 0) ? (bx % 8) * (F.G / 8) + bx / 8 : bx; }
    unsigned char* ws = args.ws;
    F.ctl = (gu32*)(ws + WS_CTL);
    for (int u = F.tid; u < (LDS_BYTES - LDSCTL_OFF) / 4; u += NWAVES * 64) ((LAS unsigned*)(F.lds + LDSCTL_OFF))[u] = 0u;
    __syncthreads();
    if (F.tid == 0) { LAS unsigned long long* pt = (LAS unsigned long long*)(F.lds + PTR_OFF);
#pragma unroll
        for (int i = 0; i < 24; ++i) pt[i] = (unsigned long long)args.in[i]; }
    __syncthreads();
    XcdBarrier bar; bar.bar = (unsigned*)(F.ctl + CW_BAR); bar.x = 0; bar.st = nullptr;
    if (MK_SINGLE) bar = xcd_barrier_post((unsigned*)(F.ctl + CW_BAR), F.MISC + 8);
#define GRID_BAR() do { if (MK_SINGLE) xcd_barrier(bar); } while (0)
    const int lo = args.ph_lo, hi = args.ph_hi;
#define IN(k) (lo <= (k) && (k) < hi)
#define BOTH(k) (IN(k) && IN((k) + 1))
#ifndef REP_MASK
#define REP_MASK 0
#endif
#define REPEAT(k) for (int rep_ = 0; rep_ < 1 + ((REP_MASK >> (k)) & 1); ++rep_)
#define PIN() do { int l_ = (int)__builtin_amdgcn_mbcnt_hi(~0u, __builtin_amdgcn_mbcnt_lo(~0u, 0u)); asm volatile("" : "+v"(l_)); F.lane = l_; F.tid = F.wave * 64 + l_; } while (0)
#define XB ((bf16*)(ws + WS_XB))
#define H0 ((bf16*)(ws + WS_H0))
#define CAT0 ((bf16*)(ws + WS_CAT0))
#define Z1 ((bf16*)(ws + WS_X1))
#define HID ((bf16*)(ws + WS_HID))
#define Z2 ((bf16*)(ws + WS_X2))
#define H1 ((bf16*)(ws + WS_H1))
#define CAT1 ((bf16*)(ws + WS_CAT1))
#define Z3 ((bf16*)(ws + WS_X3))
#define X3Q (ws + WS_X3Q)
#define YR ((bf16*)(ws + WS_YR))
#define HIDE ((unsigned char*)args.out)

    if (IN(0)) REPEAT(0) { PIN(); p0_prologue(F, args); if (BOTH(0)) GRID_BAR(); }
    if (IN(1)) REPEAT(1) { pg8::Gemm g{XB, (const bf16*)(ws + WS_WINA), NTOK, NINA, DM}; pg8::P1Order S; S.init(NTOK, NINA, F.G, (int)blockIdx.x); S.memb = (const bf16*)(ws + WS_MEMB); S.wkv = (const bf16*)(ws + WS_WMKV);
        pg8::EpiP1 E{H0, (bf16*)(ws + WS_MEMK), (bf16*)(ws + WS_MEMVT)};
        pg8::gemm_phase<pg8::EpiP1, pg8::P1Order, PG8_ALIGN, PG8_SP2>(F.lds + RING_OFF, g, S, E, F.wave);
        if (BOTH(1)) GRID_BAR(); }
    if (IN(2)) REPEAT(2) { PIN();
        { const float* part = (const float*)((unsigned char*)args.out + DO_PART); float* c1 = (float*)((unsigned char*)args.out + DO_C1); float* c2 = (float*)((unsigned char*)args.out + DO_C2);
          for (int col = F.vcu * (NWAVES * 64) + F.tid; col < NCV; col += F.G * NWAVES * 64) { float a = 0.f, b = 0.f;
#pragma unroll
              for (int kb = 0; kb < 16; ++kb) { a += part[((size_t)kb * NCV + col) * 2]; b += part[((size_t)kb * NCV + col) * 2 + 1]; } c1[col] = a; c2[col] = b; } }
        for (int u = F.vcu; u < NTOK / 128; u += F.G) mixer_a_unit(F, args, u); if (BOTH(2)) GRID_BAR(); }
    if (IN(3)) REPEAT(3) { pg8::Gemm g{CAT0, (const bf16*)(ws + WS_WOUT), NTOK, DM, DM}; pg8::StaticOrder S; S.init(NTOK, DM, F.G, (int)blockIdx.x);
        pg8::EpiZs<2, 0, DO_ST1, 0, true, DO_ZQ> E{XB, Z1, (unsigned char*)args.out, ALPHA, F.lds + EPIP_OFF};
        pg8::gemm_phase<pg8::EpiZs<2, 0, DO_ST1, 0, true, DO_ZQ>, pg8::StaticOrder, true, PG8_SP2>(F.lds + RING_OFF, g, S, E, F.wave);
        if (BOTH(3)) GRID_BAR(); }
    if (IN(5)) REPEAT(5) { pg8::Gemm g{(const bf16*)((unsigned char*)args.out + DO_ZQ), (const bf16*)(ws + WS_WFFGU), NTOK, 2 * DFF, DM / 2}; pg8::StaticOrder S;
        S.init(NTOK, 2 * DFF, F.G, (int)blockIdx.x);
        pg8::EpiSwigluLN<DO_ST1, DO_C1, DO_C2, true> E{HID, DFF, (unsigned char*)args.out, 1.0f / (WQ_SCALE * ZQ_SCALE), F.lds + EPIP_OFF};
        pg8::gemm_phase<pg8::EpiSwigluLN<DO_ST1, DO_C1, DO_C2, true>, pg8::StaticOrder, PG8_ALIGN, PG8_SP2, 1>(F.lds + RING_OFF, g, S, E, F.wave);
        if (BOTH(5)) GRID_BAR(); }
    if (IN(6)) REPEAT(6) { pg8::Gemm g{HID, (const bf16*)(ws + WS_WFFD), NTOK, DM, DFF}; pg8::StaticOrder S; S.init(NTOK, DM, F.G, (int)blockIdx.x);
        pg8::EpiZs<1, DO_ST1, DO_ST2, 0, true, DO_ZQ> E{Z1, Z2, (unsigned char*)args.out, ALPHA, F.lds + EPIP_OFF};
        pg8::gemm_phase<pg8::EpiZs<1, DO_ST1, DO_ST2, 0, true, DO_ZQ>, pg8::StaticOrder, true, PG8_SP2>(F.lds + RING_OFF, g, S, E, F.wave);
        if (BOTH(6)) GRID_BAR(); }
    if (IN(8)) REPEAT(8) { pg8::Gemm g{(const bf16*)((unsigned char*)args.out + DO_ZQ), (const bf16*)(ws + WS_WINB), NTOK, NINB, DM / 2}; pg8::StaticOrder S;
        S.init(NTOK, NINB, F.G, (int)blockIdx.x);
        pg8::EpiLinLN<DO_ST2, DO_C1 + 2 * DFF * 4, DO_C2 + 2 * DFF * 4, true> E{H1, NINB, (unsigned char*)args.out, (const float*)(ws + WS_ROPEC), (const float*)(ws + WS_ROPES), 1.0f / (WQ_SCALE * ZQ_SCALE), F.lds + EPIP_OFF};
        pg8::gemm_phase<pg8::EpiLinLN<DO_ST2, DO_C1 + 2 * DFF * 4, DO_C2 + 2 * DFF * 4, true>, pg8::StaticOrder, PG8_ALIGN, PG8_SP2, 1>(F.lds + RING_OFF, g, S, E, F.wave);
        if (BOTH(8)) GRID_BAR(); }
    if (IN(9)) REPEAT(9) { PIN(); ret_kv_phase(F, args); if (BOTH(9)) GRID_BAR(); }
    if (IN(10)) REPEAT(10) { PIN(); ret_scan(F, args); if (BOTH(10)) GRID_BAR(); }
    if (IN(11)) REPEAT(11) { PIN(); ret_out_phase(F, args); if (BOTH(11)) GRID_BAR(); }
    if (IN(12)) REPEAT(12) { pg8::Gemm g{CAT1, (const bf16*)(ws + WS_WOUT) + (size_t)DM * DM, NTOK, DM, DM}; pg8::StaticOrder S; S.init(NTOK, DM, F.G, (int)blockIdx.x);
        pg8::EpiZs<1, DO_ST2, DO_ST1, DM> E{Z2, Z3, (unsigned char*)args.out, ALPHA, F.lds + EPIP_OFF};
        pg8::gemm_phase<pg8::EpiZs<1, DO_ST2, DO_ST1, DM>, pg8::StaticOrder, true, PG8_SP2>(F.lds + RING_OFF, g, S, E, F.wave);
        if (BOTH(12)) GRID_BAR(); }
    if (IN(13)) REPEAT(13) { PIN(); ln_router(F, args, Z3, inp(F, 14) + 2 * DM, inp(F, 15) + 2 * DM, X3Q); if (BOTH(13)) GRID_BAR(); }
    if (IN(14)) REPEAT(14) { PIN(); route_positions(F, args); if (BOTH(14)) GRID_BAR(); }
    if (IN(15)) REPEAT(15) {
        const int NP = *(const int*)(F.ctl + CW_NP); const int* rowtok = (const int*)(ws + WS_ROWTOK);
        const LAS int* pe = (const LAS int*)(F.lds + EPIP_OFF);
        { PIN(); const int* peg = (const int*)(F.ctl + CW_PE); for (int i = F.tid; i < 272; i += NWAVES * 64) ((LAS int*)(F.lds + EPIP_OFF))[i] = peg[i]; __syncthreads(); }
        const int slo = args.sub_lo, shi = args.sub_hi, plo = args.pass_lo, phi = args.pass_hi;
        for (int p = plo; p < phi; ++p) { const int p0 = p * PASS_PANELS; int npp = NP - p0; if (p + 1 < MAX_PASSES && npp > PASS_PANELS) npp = PASS_PANELS; if (npp <= 0) break;
            if (slo <= 0 && 0 < shi) { pg8::Gemm g{(const bf16*)X3Q, (const bf16*)(ws + WS_WEGU), npp * 256, 2 * DFFE, DM / 2}; pg8::MoeOrder S; S.init(npp * 256, 2 * DFFE, F.G, (int)blockIdx.x); S.pe = pe + p0; S.nbt = 2 * DFFE / 256; S.rowtok = rowtok + p0 * 256;
                pg8::EpiSwiglu8 E{HIDE, DFFE, 1.0f / (WQ_SCALE * ZQ_SCALE)};
                pg8::gemm_phase<pg8::EpiSwiglu8, pg8::MoeOrder, PG8_ALIGN, PG8_SP2, 1, true>(F.lds + RING_OFF, g, S, E, F.wave);
                if (1 < shi) GRID_BAR(); }
            if (slo <= 1 && 1 < shi) { const int npm = npp < PASS_PANELS ? npp : PASS_PANELS;
                { pg8::Gemm g{(const bf16*)HIDE, (const bf16*)(ws + WS_WED), npm * 256, DM, DFFE / 2, 0}; pg8::MoeOrder S; S.init(npm * 256, DM, F.G, (int)blockIdx.x); S.pe = pe + p0; S.nbt = DM / 256; S.rowtok = nullptr;
                  pg8::EpiAct E{YR, DM, 0, p0 * 256};
                  pg8::gemm_phase<pg8::EpiAct, pg8::MoeOrder, PG8_ALIGN, PG8_SP2, 0x78, true>(F.lds + RING_OFF, g, S, E, F.wave); }
                if (npp > PASS_PANELS) {
                  pg8::Gemm g{(const bf16*)HIDE, (const bf16*)(ws + WS_WED), npp * 256, DM, 256, DFFE / 2}; pg8::SplitOrder S; S.init(npp * 256, DM, F.G, (int)blockIdx.x); S.pe = pe + p0; S.pm0 = PASS_PANELS; S.npt = npp - PASS_PANELS;
                  pg8::EpiPart E{(float*)(ws + WS_PARTY), PASS_PANELS};
                  pg8::gemm_phase<pg8::EpiPart, pg8::SplitOrder, PG8_ALIGN, PG8_SP2, 0x78, true>(F.lds + RING_OFF, g, S, E, F.wave); }
                if (MK_SINGLE) GRID_BAR(); }
        }
    }
    if (IN(16)) REPEAT(16) { PIN(); final_rows(F, args); }
#undef IN
#undef BOTH
#undef GRID_BAR
#undef XB
#undef H0
#undef CAT0
#undef Z1
#undef HID
#undef Z2
#undef H1
#undef CAT1
#undef Z3
#undef X3Q
#undef YR
#undef HIDE
}

extern "C" void kernel_launch(void* const* d_in, const int* in_sizes, int n_in, void* d_out, int out_size, void* d_ws, size_t ws_size, hipStream_t stream) {
    static int grid = 0;
    if (grid == 0) {
        if (n_in != 24 || in_sizes[0] != NTOK * DM || out_size != NTOK * DM || ws_size < WS_END) { fprintf(stderr, "kernel_launch: unexpected shapes (n_in %d, in0 %d, out %d, ws %zu < %zu); nothing launched\n", n_in, n_in > 0 ? in_sizes[0] : -1, out_size, ws_size, (size_t)WS_END); grid = -1; return; }
        int dev = 0, cus = 0, per_cu = 0;
        if (hipGetDevice(&dev) != hipSuccess || hipDeviceGetAttribute(&cus, hipDeviceAttributeMultiprocessorCount, dev) != hipSuccess) { grid = -1; return; }
        if (hipFuncSetAttribute((const void*)hyb_fwd, hipFuncAttributeMaxDynamicSharedMemorySize, LDS_BYTES) != hipSuccess) { fprintf(stderr, "kernel_launch: hipFuncSetAttribute failed\n"); grid = -1; return; }
        if (hipOccupancyMaxActiveBlocksPerMultiprocessor(&per_cu, (const void*)hyb_fwd, NWAVES * 64, LDS_BYTES) != hipSuccess || per_cu < 1)
            fprintf(stderr, "kernel_launch: note: occupancy query reports %d workgroups per CU\n", per_cu);
        (void)hipGetLastError();
        grid = cus;
    }
    if (grid < 0) return;
    if (hipMemsetAsync((char*)d_ws + WS_CTL, 0, CTL_ZERO_BYTES, stream) != hipSuccess) { fprintf(stderr, "kernel_launch: hipMemsetAsync failed\n"); return; }
    Args a{};
    for (int i = 0; i < 24; ++i) a.in[i] = (const float*)d_in[i];
    a.out = (float*)d_out; a.ws = (unsigned char*)d_ws;
#if MK_SINGLE
    a.ph_lo = 0; a.ph_hi = N_PHASES; a.pass_lo = 0; a.pass_hi = MAX_PASSES; a.sub_lo = 0; a.sub_hi = 2; a.li = 0;
    hipLaunchKernelGGL(hyb_fwd, dim3(grid), dim3(NWAVES * 64), LDS_BYTES, stream, a);
#else
    for (int ph = 0; ph < N_PHASES; ++ph) {
        a.ph_lo = ph; a.ph_hi = ph + 1; a.li = 0;
        if (ph != 15) { a.pass_lo = 0; a.pass_hi = 0; a.sub_lo = 0; a.sub_hi = 0; hipLaunchKernelGGL(hyb_fwd, dim3(grid), dim3(NWAVES * 64), LDS_BYTES, stream, a); }
        else for (int p = 0; p < MAX_PASSES; ++p) for (int s = 0; s < 2; ++s) { a.pass_lo = p; a.pass_hi = p + 1; a.sub_lo = s; a.sub_hi = s + 1; hipLaunchKernelGGL(hyb_fwd, dim3(grid), dim3(NWAVES * 64), LDS_BYTES, stream, a); }
    }
#endif
    const hipError_t le = hipPeekAtLastError();
    if (le != hipSuccess) fprintf(stderr, "kernel_launch: launch failed: %s\n", hipGetErrorName(le));
}
```

```cpp
#include <hip/hip_runtime.h>
#include <cstdio>
#include <cstdint>
#include <cmath>
#define REP_MASK 0
#define REP_EPI 0
namespace pg8 {
#define PG8_LAS __attribute__((address_space(3)))
#define PG8_GAS __attribute__((address_space(1)))
typedef unsigned short bf16_t;
typedef short bf16x8 __attribute__((ext_vector_type(8)));
typedef float f32x4 __attribute__((ext_vector_type(4)));
typedef unsigned u32x4 __attribute__((ext_vector_type(4)));
typedef int i32x4 __attribute__((ext_vector_type(4)));
constexpr int BM = 256, BK = 64, HALF = 128, HTB = HALF * BK * 2  , STAGE_BYTES = 8 * HTB, NXCD = 8, WGM = 8;

__host__ __device__ __forceinline__ int lds_byte(int r, int c) { const int st = (r >> 4) * 2 + (c >> 5), rr = r & 15, cc = c & 31, ob = rr * 64 + cc * 2; return st * 1024 + (ob ^ (((ob >> 9) & 1) << 5)); }
__host__ __device__ __forceinline__ void stage_rc(int b, int& R, int& C) { const int st = b / 1024, sb = b % 1024, swz = sb ^ (((sb >> 9) & 1) << 5); R = (st >> 1) * 16 + swz / 64; C = (st & 1) * 32 + (swz % 64) / 2; }
__host__ __device__ __forceinline__ int perm32(int rho) { const int n = rho >> 4, i = rho & 15; return 8 * (i >> 2) + 4 * n + (i & 3); }

struct Unit { int pm, pn, job; };
struct Gemm { const bf16_t* A; const bf16_t* Bt; int M, N, K; int ld; };

struct StaticOrder {
    int nM, nN, nwg, G, c; unsigned mnig;
    __host__ __device__ void init(int M, int N, int G_, int c_) { nM = M / BM; nN = N / BM; nwg = nM * nN; G = G_; c = c_; mnig = (unsigned)((0x100000000ull + (unsigned)(WGM * nN) - 1u) / (unsigned)(WGM * nN)); }
    __host__ __device__ bool next(int i, Unit& u) const {
        const long L = (long)i * G + c; if (L >= nwg) return false;
        int wgid = (int)L; { const int q = nwg / NXCD, r = nwg % NXCD, xcd = wgid % NXCD, off = wgid / NXCD; wgid = (xcd < r ? xcd * (q + 1) : r * (q + 1) + (xcd - r) * q) + off; }
        const int nig = WGM * nN, gid = (int)(((unsigned long long)(unsigned)wgid * mnig) >> 32), rem = wgid - gid * nig, fm = gid * WGM;
        if (nM - fm >= WGM) { u.pm = fm + (rem & (WGM - 1)); u.pn = rem / WGM; }
        else { const int gsz = nM - fm; u.pm = fm + rem % gsz; u.pn = rem / gsz; }
        u.job = 0; return true;
    }
    __device__ __forceinline__ const char* a_ptr(const Gemm& g, const Unit& u, size_t tstep) const { return (const char*)g.A + (size_t)u.pm * tstep; }
    __device__ __forceinline__ const char* b_ptr(const Gemm& g, const Unit& u, size_t tstep) const { return (const char*)g.Bt + (size_t)u.pn * tstep; }
    __device__ __forceinline__ int row_token(const Unit& u, int r) const { return u.pm * BM + r; }
    __device__ __forceinline__ void a_ready(const Unit&) const {}
    __device__ __forceinline__ void done(const Unit&) const {}
};

__device__ __forceinline__ unsigned cvt_pk_bf16(float lo, float hi) { unsigned r; asm volatile("v_cvt_pk_bf16_f32 %0, %1, %2" : "=v"(r) : "v"(lo), "v"(hi)); return r; }
typedef float f32x2 __attribute__((ext_vector_type(2)));
__device__ __forceinline__ f32x2 gelu_pk(f32x2 v) {
    const f32x2 av = __builtin_elementwise_abs(v), d = av * 0.2316418882f + 1.0f;
    f32x2 t; t.x = __builtin_amdgcn_rcpf(d.x); t.y = __builtin_amdgcn_rcpf(d.y);
    f32x2 q = t * 0.5307027145f + (-0.7265760135f); q = q * t + 0.7107068705f; q = q * t + (-0.142248368f); q = q * t + 0.127414796f; q = q * t;
    const f32x2 s = (v * v) * (-0.72134752044f);
    f32x2 e; e.x = __builtin_amdgcn_exp2f(s.x); e.y = __builtin_amdgcn_exp2f(s.y);
    const f32x2 m = v * (q * e), r = v - m;
    f32x2 o; o.x = v.x < 0.f ? m.x : r.x; o.y = v.y < 0.f ? m.y : r.y; return o;
}
template <int CTRL> __device__ __forceinline__ float dpp_f(float x) { return __builtin_bit_cast(float, __builtin_amdgcn_update_dpp(0, __builtin_bit_cast(int, x), CTRL, 0xf, 0xf, true)); }
constexpr int DPP_X1 = 0xB1  , DPP_X2 = 0x4E  , DPP_HM = 0x141  , DPP_RM = 0x140  ;
__device__ __forceinline__ float sum8(float v) { v += dpp_f<DPP_X1>(v); v += dpp_f<DPP_X2>(v); v += dpp_f<DPP_HM>(v); return v; }
__device__ __forceinline__ float sum16(float v) { v = sum8(v); v += dpp_f<DPP_RM>(v); return v; }
__device__ __forceinline__ float xsum16(float x) { const auto r = __builtin_amdgcn_permlane16_swap(__float_as_uint(x), __float_as_uint(x), false, false); return __uint_as_float(r[0]) + __uint_as_float(r[1]); }
__device__ __forceinline__ float xsum32(float x) { const auto r = __builtin_amdgcn_permlane32_swap(__float_as_uint(x), __float_as_uint(x), false, false); return __uint_as_float(r[0]) + __uint_as_float(r[1]); }
__device__ __forceinline__ float xmax16(float x) { const auto r = __builtin_amdgcn_permlane16_swap(__float_as_uint(x), __float_as_uint(x), false, false); return fmaxf(__uint_as_float(r[0]), __uint_as_float(r[1])); }
__device__ __forceinline__ float xmax32(float x) { const auto r = __builtin_amdgcn_permlane32_swap(__float_as_uint(x), __float_as_uint(x), false, false); return fmaxf(__uint_as_float(r[0]), __uint_as_float(r[1])); }
__device__ __forceinline__ unsigned q8x4(float a, float b, float c, float d) {
    const float M = 12582912.0f;
    const unsigned ua = __float_as_uint(__builtin_amdgcn_fmed3f(a, -127.f, 127.f) + M), ub = __float_as_uint(__builtin_amdgcn_fmed3f(b, -127.f, 127.f) + M),
                   uc = __float_as_uint(__builtin_amdgcn_fmed3f(c, -127.f, 127.f) + M), ud = __float_as_uint(__builtin_amdgcn_fmed3f(d, -127.f, 127.f) + M);
    return __builtin_amdgcn_perm(ub, ua, 0x0c0c0400u) | __builtin_amdgcn_perm(ud, uc, 0x04000c0cu);
}
__device__ __forceinline__ float silu_f(float x) { return x * __builtin_amdgcn_rcpf(1.0f + __builtin_amdgcn_exp2f(-1.44269504089f * x)); }
struct EpiAct {
    static constexpr bool PERM = true, AFTER_DRAIN = false;
    bf16_t* O; int ldc; int ngelu; int row_off;
    __device__ __forceinline__ void operator()(const f32x4 (&acc)[2][2][4][2], const Unit& u, int wr, int wc, int fr, int fq) const {
        int row0 = row_off + u.pm * BM + wr * 64 + fr; int col0 = u.pn * BM + wc * 32 + 8 * fq; asm volatile("" : "+v"(row0), "+v"(col0));
        const PG8_GAS char* ob = (const PG8_GAS char*)O; const unsigned off0 = ((unsigned)row0 * (unsigned)ldc + (unsigned)col0) * 2u, dstep = (unsigned)ldc * 32u;
        const bool act = u.pn < ngelu;
#pragma unroll
        for (int ai = 0; ai < 2; ++ai)
#pragma unroll
            for (int m = 0; m < 4; ++m) { const unsigned off = off0 + (unsigned)(ai * 8 + m) * dstep;
#pragma unroll
                for (int bj = 0; bj < 2; ++bj) { f32x4 v0 = acc[ai][bj][m][0], v1 = acc[ai][bj][m][1];
                    if (act) { f32x2 a = gelu_pk((f32x2){v0[0], v0[1]}), b = gelu_pk((f32x2){v0[2], v0[3]}), c = gelu_pk((f32x2){v1[0], v1[1]}), d = gelu_pk((f32x2){v1[2], v1[3]});
                        v0 = (f32x4){a.x, a.y, b.x, b.y}; v1 = (f32x4){c.x, c.y, d.x, d.y}; }
                    u32x4 w; w.x = cvt_pk_bf16(v0[0], v0[1]); w.y = cvt_pk_bf16(v0[2], v0[3]); w.z = cvt_pk_bf16(v1[0], v1[1]); w.w = cvt_pk_bf16(v1[2], v1[3]);
                    *(PG8_GAS u32x4*)(ob + off + bj * (HALF * 2)) = w; } }
    }
};
struct EpiSwiglu {
    static constexpr bool PERM = true, AFTER_DRAIN = false;
    bf16_t* O; int ldc;
    __device__ __forceinline__ void operator()(const f32x4 (&acc)[2][2][4][2], const Unit& u, int wr, int wc, int fr, int fq) const {
        int row0 = u.pm * BM + wr * 64 + fr; int col0 = u.pn * HALF + wc * 32 + 8 * fq; asm volatile("" : "+v"(row0), "+v"(col0));
#pragma unroll
        for (int ai = 0; ai < 2; ++ai)
#pragma unroll
            for (int m = 0; m < 4; ++m) { bf16_t* rowp = O + (size_t)(row0 + ai * HALF + m * 16) * ldc + col0;
                const f32x4 g0 = acc[ai][0][m][0], g1 = acc[ai][0][m][1], u0 = acc[ai][1][m][0], u1 = acc[ai][1][m][1];
                u32x4 w; w.x = cvt_pk_bf16(silu_f(g0[0]) * u0[0], silu_f(g0[1]) * u0[1]); w.y = cvt_pk_bf16(silu_f(g0[2]) * u0[2], silu_f(g0[3]) * u0[3]);
                w.z = cvt_pk_bf16(silu_f(g1[0]) * u1[0], silu_f(g1[1]) * u1[1]); w.w = cvt_pk_bf16(silu_f(g1[2]) * u1[2], silu_f(g1[3]) * u1[3]);
                *(u32x4*)rowp = w; }
    }
};
struct EpiSwiglu8 {
    static constexpr bool PERM = true, AFTER_DRAIN = false; static constexpr int REP = 2;
    unsigned char* O; int ldc; float qs;
    __device__ __forceinline__ void operator()(const f32x4 (&acc)[2][2][4][2], const Unit& u, int wr, int wc, int fr, int fq) const {
        int row0 = u.pm * BM + wr * 64 + fr; int col0 = u.pn * HALF + wc * 32 + 8 * fq; asm volatile("" : "+v"(row0), "+v"(col0));
        const int radj = (fq & 1) ? 16 : 0, cadj = (fq & 1) ? -8 : 0;
        const float iq2 = 1.0f / (qs * qs), ce = -1.44269504089f * qs, le = __builtin_log2f(iq2);
#pragma unroll
        for (int ai = 0; ai < 2; ++ai)
#pragma unroll
            for (int mp = 0; mp < 2; ++mp) { unsigned char* rowp = O + (size_t)(row0 + ai * HALF + mp * 32 + radj) * ldc + col0 + cadj;
                unsigned w[2][2];
#pragma unroll
                for (int h = 0; h < 2; ++h) { const int m = mp * 2 + h;
                    const f32x4 g0 = __builtin_convertvector(__builtin_bit_cast(i32x4, acc[ai][0][m][0]), f32x4), g1 = __builtin_convertvector(__builtin_bit_cast(i32x4, acc[ai][0][m][1]), f32x4),
                                u0 = __builtin_convertvector(__builtin_bit_cast(i32x4, acc[ai][1][m][0]), f32x4), u1 = __builtin_convertvector(__builtin_bit_cast(i32x4, acc[ai][1][m][1]), f32x4);
#define SWQ(G, U) (((G) * (U)) * __builtin_amdgcn_rcpf(iq2 + __builtin_amdgcn_exp2f((G) * ce + le)))
                    int w0 = __builtin_amdgcn_cvt_pk_fp8_f32(SWQ(g0[0], u0[0]), SWQ(g0[1], u0[1]), 0, false); w0 = __builtin_amdgcn_cvt_pk_fp8_f32(SWQ(g0[2], u0[2]), SWQ(g0[3], u0[3]), w0, true);
                    int w1 = __builtin_amdgcn_cvt_pk_fp8_f32(SWQ(g1[0], u1[0]), SWQ(g1[1], u1[1]), 0, false); w1 = __builtin_amdgcn_cvt_pk_fp8_f32(SWQ(g1[2], u1[2]), SWQ(g1[3], u1[3]), w1, true);
#undef SWQ
                    w[h][0] = (unsigned)w0; w[h][1] = (unsigned)w1; }
                const auto s0 = __builtin_amdgcn_permlane16_swap(w[0][0], w[1][0], false, false), s1 = __builtin_amdgcn_permlane16_swap(w[0][1], w[1][1], false, false);
                *(u32x4*)rowp = (u32x4){s0[0], s1[0], s0[1], s1[1]}; }
    }
};
template <bool BASE_BF16> struct EpiZ {
    static constexpr bool PERM = false, AFTER_DRAIN = false;
    const void* base; float* Z; float alpha;
    __device__ __forceinline__ void operator()(const f32x4 (&acc)[2][2][4][2], const Unit& u, int wr, int wc, int fr, int fq) const {
        int row0 = u.pm * BM + wr * 64 + fr; int col0 = u.pn * BM + wc * 32 + 4 * fq; asm volatile("" : "+v"(row0), "+v"(col0));
#pragma unroll
        for (int ai = 0; ai < 2; ++ai)
#pragma unroll
            for (int m = 0; m < 4; ++m) { const size_t off = (size_t)(row0 + ai * HALF + m * 16) * 1024 + col0;
#pragma unroll
                for (int bj = 0; bj < 2; ++bj)
#pragma unroll
                    for (int n = 0; n < 2; ++n) { const size_t o2 = off + bj * HALF + n * 16; f32x4 b;
                        if (BASE_BF16) { const uint2 r = *(const uint2*)((const bf16_t*)base + o2); b = (f32x4){__uint_as_float(r.x << 16), __uint_as_float(r.x & 0xffff0000u), __uint_as_float(r.y << 16), __uint_as_float(r.y & 0xffff0000u)}; }
                        else b = *(const f32x4*)((const float*)base + o2);
                        *(f32x4*)(Z + o2) = b * alpha + acc[ai][bj][m][n]; } }
    }
};
__device__ __forceinline__ void row_mu_r(const float* ST, int row, float& mu, float& r) {
    const f32x4 a = *(const f32x4*)(ST + (size_t)row * 8), b = *(const f32x4*)(ST + (size_t)row * 8 + 4);
    const float s1 = (a[0] + a[2]) + (b[0] + b[2]), s2 = (a[1] + a[3]) + (b[1] + b[3]);
    mu = s1 * (1.0f / 1024.0f); const float var = s2 * (1.0f / 1024.0f) - mu * mu; r = 1.0f / sqrtf(var + 1e-5f);
}
constexpr int EPIS_REL = 8192;
typedef float f32x2s __attribute__((ext_vector_type(2)));
__device__ __forceinline__ void panel_mu_r(const float* ST, int pm, int t, PG8_LAS unsigned char* lp) {
    const f32x4 v = *(const f32x4*)(ST + (size_t)(pm * BM + (t >> 1)) * 8 + (t & 1) * 4);
    float s1 = v[0] + v[2], s2 = v[1] + v[3]; s1 += dpp_f<DPP_X1>(s1); s2 += dpp_f<DPP_X1>(s2);
    const float mean = s1 * (1.0f / 1024.0f), var = s2 * (1.0f / 1024.0f) - mean * mean;
    if ((t & 1) == 0) *(PG8_LAS f32x2s*)(lp + EPIS_REL + (t >> 1) * 8) = (f32x2s){mean, 1.0f / sqrtf(var + 1e-5f)};
    asm volatile("s_waitcnt lgkmcnt(0)" ::: "memory"); __builtin_amdgcn_s_barrier(); asm volatile("" ::: "memory");
}
__device__ __forceinline__ f32x2s row_mr(PG8_LAS unsigned char* lp, int prow) { return *(const PG8_LAS f32x2s*)(lp + EPIS_REL + prow * 8); }
__device__ __forceinline__ void unpack8(const u32x4 w, f32x4& lo, f32x4& hi) {
    lo = (f32x4){__uint_as_float(w.x << 16), __uint_as_float(w.x & 0xffff0000u), __uint_as_float(w.y << 16), __uint_as_float(w.y & 0xffff0000u)};
    hi = (f32x4){__uint_as_float(w.z << 16), __uint_as_float(w.z & 0xffff0000u), __uint_as_float(w.w << 16), __uint_as_float(w.w & 0xffff0000u)};
}
template <int BASE  , size_t ST_IN, size_t ST_OUT, int LNOFF, bool ZQ = false, size_t ZQ_OFF = 0, bool I8 = false  > struct EpiZs {
    static constexpr bool BASE_LN = BASE == 1;
    static constexpr bool PERM = true, AFTER_DRAIN = false; static constexpr int REP = 1;
    const void* base; bf16_t* Z; unsigned char* sbase; float alpha; PG8_LAS unsigned char* lp; float qs = 1.0f;
    __device__ __forceinline__ f32x4 cva(const f32x4 a) const { return I8 ? __builtin_convertvector(__builtin_bit_cast(i32x4, a), f32x4) * qs : a; }
    __device__ __forceinline__ void operator()(const f32x4 (&acc)[2][2][4][2], const Unit& u, int wr, int wc, int fr, int fq) const {
        int row0 = u.pm * BM + wr * 64 + fr; int col0 = u.pn * BM + wc * 32 + 8 * fq; asm volatile("" : "+v"(row0), "+v"(col0));
        const int prow0 = row0 & 255, tq = (prow0 >> 6) * 256 + (prow0 & 15) + ((col0 >> 5) & 3) * 64 + ((col0 >> 3) & 3) * 16;
        float* const STo = (float*)(sbase + ST_OUT); const float* const STp = (const float*)(sbase + ST_IN);
        const float* g = nullptr; const float* b = nullptr;
        if (BASE_LN) { const volatile PG8_LAS unsigned* pt = (const volatile PG8_LAS unsigned*)(lp - 1024);
            const unsigned g0_ = __builtin_amdgcn_readfirstlane(pt[28]), g1_ = __builtin_amdgcn_readfirstlane(pt[29]), b0_ = __builtin_amdgcn_readfirstlane(pt[30]), b1_ = __builtin_amdgcn_readfirstlane(pt[31]);
            g = (const float*)(((unsigned long long)g1_ << 32) | g0_) + LNOFF; b = (const float*)(((unsigned long long)b1_ << 32) | b0_) + LNOFF; }
        f32x4 gv[2][2], bv[2][2];
        if (BASE_LN) {
#pragma unroll
            for (int bj = 0; bj < 2; ++bj)
#pragma unroll
                for (int n = 0; n < 2; ++n) { gv[bj][n] = *(const f32x4*)(g + col0 + bj * HALF + 4 * n) * alpha; bv[bj][n] = *(const f32x4*)(b + col0 + bj * HALF + 4 * n) * alpha; } }
        typedef float f32x2v __attribute__((ext_vector_type(2)));
        PG8_LAS f32x2v* P = (PG8_LAS f32x2v*)lp;
        if (BASE_LN) panel_mu_r(STp, u.pm, tq, lp);
        f32x4 z[2][4][2][2];
        constexpr int W = BASE_LN ? 8 : 16;
        u32x4 raw[16];
#define EPZ_OFF(k) ((unsigned)(row0 + ((k) >> 3) * HALF + (((k) >> 1) & 3) * 16) * 1024u + (unsigned)col0 + ((k) & 1) * HALF)
        if (BASE != 0) {
#pragma unroll
            for (int k = 0; k < W; ++k) raw[k] = *(const PG8_GAS u32x4*)((const PG8_GAS char*)base + EPZ_OFF(k) * 2u); }
#pragma unroll
        for (int k = 0; k < 16; ++k) { const int ai = k >> 3, m = (k >> 1) & 3, bj = k & 1;
            if (BASE_LN) { const f32x2s mr = row_mr(lp, prow0 + ai * HALF + m * 16); f32x4 p0, p1; unpack8(raw[k], p0, p1);
                z[ai][m][bj][0] = (p0 - mr.x) * mr.y * gv[bj][0] + bv[bj][0] + cva(acc[ai][bj][m][0]); z[ai][m][bj][1] = (p1 - mr.x) * mr.y * gv[bj][1] + bv[bj][1] + cva(acc[ai][bj][m][1]); }
            else if (BASE == 2) { f32x4 p0, p1; unpack8(raw[k], p0, p1); z[ai][m][bj][0] = p0 * alpha + cva(acc[ai][bj][m][0]); z[ai][m][bj][1] = p1 * alpha + cva(acc[ai][bj][m][1]); }
            else { z[ai][m][bj][0] = *(const f32x4*)((const float*)base + EPZ_OFF(k)) * alpha + cva(acc[ai][bj][m][0]); z[ai][m][bj][1] = *(const f32x4*)((const float*)base + EPZ_OFF(k) + 4) * alpha + cva(acc[ai][bj][m][1]); }
            asm volatile("" : "+v"(z[ai][m][bj][0]), "+v"(z[ai][m][bj][1]));
            if (BASE != 0 && k + W < 16) raw[k + W] = *(const PG8_GAS u32x4*)((const PG8_GAS char*)base + EPZ_OFF(k + W) * 2u); }
#undef EPZ_OFF
        int row0b = row0; asm volatile("" : "+v"(row0b));
#pragma unroll
        for (int ai = 0; ai < 2; ++ai) { unsigned qk[2][2] = {{0u, 0u}, {0u, 0u}};
#pragma unroll
            for (int m = 0; m < 4; ++m) { const int row = row0b + ai * HALF + m * 16; const unsigned off = (unsigned)row * 1024u + (unsigned)col0;
                float s1 = 0.f, s2 = 0.f;
#pragma unroll
                for (int bj = 0; bj < 2; ++bj) { const f32x4 z0 = z[ai][m][bj][0], z1 = z[ai][m][bj][1];
                    u32x4 w; w.x = cvt_pk_bf16(z0[0], z0[1]); w.y = cvt_pk_bf16(z0[2], z0[3]); w.z = cvt_pk_bf16(z1[0], z1[1]); w.w = cvt_pk_bf16(z1[2], z1[3]);
                    *(PG8_GAS u32x4*)((PG8_GAS char*)Z + (off + bj * HALF) * 2u) = w;
                    f32x4 y0, y1; unpack8(w, y0, y1);
                    if (ZQ) { const f32x4 s0_ = y0 * 20.0f, s1_ = y1 * 20.0f;
                        const unsigned q0 = q8x4(s0_[0], s0_[1], s0_[2], s0_[3]), q1 = q8x4(s1_[0], s1_[1], s1_[2], s1_[3]);
                        if ((m & 1) == 0) { qk[bj][0] = q0; qk[bj][1] = q1; }
                        else {
                            const auto t0 = __builtin_amdgcn_permlane16_swap(qk[bj][0], q0, false, false), t1 = __builtin_amdgcn_permlane16_swap(qk[bj][1], q1, false, false);
                            *(PG8_GAS u32x4*)((PG8_GAS char*)(sbase + ZQ_OFF) + (off + bj * HALF - ((fq & 1) ? 8u : 16u * 1024u))) = (u32x4){t0[0], t1[0], t0[1], t1[1]}; } }
                    s1 += ((y0[0] + y0[1]) + (y0[2] + y0[3])) + ((y1[0] + y1[1]) + (y1[2] + y1[3]));
                    s2 += ((y0[0] * y0[0] + y0[1] * y0[1]) + (y0[2] * y0[2] + y0[3] * y0[3])) + ((y1[0] * y1[0] + y1[1] * y1[1]) + (y1[2] * y1[2] + y1[3] * y1[3])); }
                s1 = xsum32(xsum16(s1)); s2 = xsum32(xsum16(s2));
                if (fq == 0) P[(ai * HALF + wr * 64 + m * 16 + fr) * 4 + wc] = (f32x2v){s1, s2}; } }
        asm volatile("s_waitcnt lgkmcnt(0)" ::: "memory"); __builtin_amdgcn_s_barrier(); asm volatile("" ::: "memory");
        const int t = (wr * 4 + wc) * 64 + fq * 16 + fr;
        if (t < 256) { const f32x2v a = P[t * 4 + 0], b2 = P[t * 4 + 1], c = P[t * 4 + 2], d = P[t * 4 + 3];
            *(f32x2v*)(STo + ((size_t)(u.pm * BM + t) * 4 + u.pn) * 2) = (f32x2v){(a.x + b2.x) + (c.x + d.x), (a.y + b2.y) + (c.y + d.y)}; }
    }
};
template <size_t ST_IN, size_t C1_OFF, size_t C2_OFF, bool I8 = false, bool O8 = false> struct EpiSwigluLN {
    static constexpr bool PERM = true, AFTER_DRAIN = false; static constexpr int NST = O8 ? 4 : 8;
    bf16_t* O; int ldc; unsigned char* sbase; float qs; PG8_LAS unsigned char* lp; float hq = 1.0f;
    __device__ __forceinline__ void operator()(const f32x4 (&acc)[2][2][4][2], const Unit& u, int wr, int wc, int fr, int fq) const {
        int row0 = u.pm * BM + wr * 64 + fr; int col0 = u.pn * HALF + wc * 32 + 8 * fq; asm volatile("" : "+v"(row0), "+v"(col0));
        const int prow0 = row0 & 255, tq = (prow0 >> 6) * 256 + (prow0 & 15) + ((col0 >> 5) & 3) * 64 + ((col0 >> 3) & 3) * 16;
        const float* const ST = (const float*)(sbase + ST_IN); const float* const c1 = (const float*)(sbase + C1_OFF); const float* const c2 = (const float*)(sbase + C2_OFF);
        const int cc = u.pn * BM + wc * 32 + 8 * fq;
        f32x4 a1[2][2], a2[2][2];
#pragma unroll
        for (int bj = 0; bj < 2; ++bj)
#pragma unroll
            for (int n = 0; n < 2; ++n) { a1[bj][n] = *(const f32x4*)(c1 + cc + bj * HALF + 4 * n); a2[bj][n] = *(const f32x4*)(c2 + cc + bj * HALF + 4 * n); }
        if (O8) {
#pragma unroll
            for (int n = 0; n < 2; ++n) { a1[1][n] = a1[1][n] * hq; a2[1][n] = a2[1][n] * hq; } }
        panel_mu_r(ST, u.pm, tq, lp);
        const int radj = (fq & 1) ? 16 : 0, cadj = (fq & 1) ? -8 : 0;
#pragma unroll
        for (int ai = 0; ai < 2; ++ai)
#pragma unroll
            for (int mp = 0; mp < 2; ++mp) { unsigned w8[2][2];
#pragma unroll
                for (int hh = 0; hh < 2; ++hh) { const int m = 2 * mp + hh; const int row = row0 + ai * HALF + m * 16; bf16_t* rowp = O + (size_t)row * ldc + col0;
                    const f32x2s mr = row_mr(lp, prow0 + ai * HALF + m * 16); const float mu = mr.x, r = mr.y;
                    f32x4 c00 = acc[ai][0][m][0], c01 = acc[ai][0][m][1], c10 = acc[ai][1][m][0], c11 = acc[ai][1][m][1];
                    if (I8) { c00 = __builtin_convertvector(__builtin_bit_cast(i32x4, c00), f32x4); c01 = __builtin_convertvector(__builtin_bit_cast(i32x4, c01), f32x4);
                              c10 = __builtin_convertvector(__builtin_bit_cast(i32x4, c10), f32x4); c11 = __builtin_convertvector(__builtin_bit_cast(i32x4, c11), f32x4); }
                    const float qr = (I8 ? qs : 1.0f) * r, mur = mu * r, qru = O8 ? qr * hq : qr;
                    const f32x4 g0 = c00 * qr + (a2[0][0] - a1[0][0] * mur), g1 = c01 * qr + (a2[0][1] - a1[0][1] * mur);
                    const f32x4 u0 = c10 * qru + (a2[1][0] - a1[1][0] * mur), u1 = c11 * qru + (a2[1][1] - a1[1][1] * mur);
                    if (O8) { w8[hh][0] = q8x4(silu_f(g0[0]) * u0[0], silu_f(g0[1]) * u0[1], silu_f(g0[2]) * u0[2], silu_f(g0[3]) * u0[3]);
                              w8[hh][1] = q8x4(silu_f(g1[0]) * u1[0], silu_f(g1[1]) * u1[1], silu_f(g1[2]) * u1[2], silu_f(g1[3]) * u1[3]); }
                    else { u32x4 w; w.x = cvt_pk_bf16(silu_f(g0[0]) * u0[0], silu_f(g0[1]) * u0[1]); w.y = cvt_pk_bf16(silu_f(g0[2]) * u0[2], silu_f(g0[3]) * u0[3]);
                        w.z = cvt_pk_bf16(silu_f(g1[0]) * u1[0], silu_f(g1[1]) * u1[1]); w.w = cvt_pk_bf16(silu_f(g1[2]) * u1[2], silu_f(g1[3]) * u1[3]);
                        *(u32x4*)rowp = w; } }
                if (O8) { const auto s0 = __builtin_amdgcn_permlane16_swap(w8[0][0], w8[1][0], false, false), s1 = __builtin_amdgcn_permlane16_swap(w8[0][1], w8[1][1], false, false);
                    *(u32x4*)((unsigned char*)O + (size_t)(row0 + ai * HALF + mp * 32 + radj) * ldc + col0 + cadj) = (u32x4){s0[0], s1[0], s0[1], s1[1]}; } }
    }
};
template <size_t ST_IN, size_t C1_OFF, size_t C2_OFF, bool I8 = false> struct EpiLinLN {
    static constexpr bool PERM = true, AFTER_DRAIN = false;
    bf16_t* O; int ldc; unsigned char* sbase; const float* rc; const float* rs; float qs; PG8_LAS unsigned char* lp;
    __device__ __forceinline__ f32x4 cv(const f32x4 a) const { return I8 ? __builtin_convertvector(__builtin_bit_cast(i32x4, a), f32x4) : a; }
    __device__ __forceinline__ void operator()(const f32x4 (&acc)[2][2][4][2], const Unit& u, int wr, int wc, int fr, int fq) const {
        int row0 = u.pm * BM + wr * 64 + fr; int col0 = u.pn * BM + wc * 32 + 8 * fq; asm volatile("" : "+v"(row0), "+v"(col0));
        const int prow0 = row0 & 255, tq = (prow0 >> 6) * 256 + (prow0 & 15) + ((col0 >> 5) & 3) * 64 + ((col0 >> 3) & 3) * 16;
        const float* const ST = (const float*)(sbase + ST_IN); const float* const c1 = (const float*)(sbase + C1_OFF); const float* const c2 = (const float*)(sbase + C2_OFF);
        const PG8_GAS char* ob = (const PG8_GAS char*)O;
        f32x4 a1[2][2], a2[2][2];
#pragma unroll
        for (int bj = 0; bj < 2; ++bj)
#pragma unroll
            for (int n = 0; n < 2; ++n) { a1[bj][n] = *(const f32x4*)(c1 + col0 + bj * HALF + 4 * n); a2[bj][n] = *(const f32x4*)(c2 + col0 + bj * HALF + 4 * n); }
        panel_mu_r(ST, u.pm, tq, lp);
        if (u.pn < 3) { const int pr0 = u.pn * HALF + wc * 32 + 8 * fq, hd = pr0 / 48, d0 = pr0 - hd * 48; const float sc = hd < 4 ? 0.10206207261596577f : 1.0f;
            f32x4 rot[2][4][4];
#pragma unroll
            for (int ai = 0; ai < 2; ++ai)
#pragma unroll
                for (int m = 0; m < 4; ++m) { const int row = row0 + ai * HALF + m * 16; const f32x2s mr = row_mr(lp, prow0 + ai * HALF + m * 16); const float mu = mr.x, r = mr.y;
                    const float qr = (I8 ? qs : 1.0f) * r * sc, mur = mu * r * sc;
                    const f32x4 x0 = cv(acc[ai][0][m][0]) * qr + (a2[0][0] * sc - a1[0][0] * mur), x1 = cv(acc[ai][0][m][1]) * qr + (a2[0][1] * sc - a1[0][1] * mur);
                    const f32x4 y0 = cv(acc[ai][1][m][0]) * qr + (a2[1][0] * sc - a1[1][0] * mur), y1 = cv(acc[ai][1][m][1]) * qr + (a2[1][1] * sc - a1[1][1] * mur);
                    const size_t to = (size_t)(row & 8191) * 48 + d0; const f32x4 c0 = *(const f32x4*)(rc + to), c1v = *(const f32x4*)(rc + to + 4), s0 = *(const f32x4*)(rs + to), s1 = *(const f32x4*)(rs + to + 4);
                    rot[ai][m][0] = x0 * c0 - y0 * s0; rot[ai][m][1] = x1 * c1v - y1 * s1; rot[ai][m][2] = y0 * c0 + x0 * s0; rot[ai][m][3] = y1 * c1v + x1 * s1; }
#pragma unroll
            for (int ai = 0; ai < 2; ++ai)
#pragma unroll
                for (int m = 0; m < 4; ++m) { const int row = row0 + ai * HALF + m * 16; const f32x4 o0 = rot[ai][m][0], o1 = rot[ai][m][1], q0 = rot[ai][m][2], q1 = rot[ai][m][3];
                    const unsigned opo = ((unsigned)row * (unsigned)ldc + (unsigned)(hd * 96 + d0)) * 2u;
                    u32x4 w; w.x = cvt_pk_bf16(o0[0], o0[1]); w.y = cvt_pk_bf16(o0[2], o0[3]); w.z = cvt_pk_bf16(o1[0], o1[1]); w.w = cvt_pk_bf16(o1[2], o1[3]); *(PG8_GAS u32x4*)(ob + opo) = w;
                    w.x = cvt_pk_bf16(q0[0], q0[1]); w.y = cvt_pk_bf16(q0[2], q0[3]); w.z = cvt_pk_bf16(q1[0], q1[1]); w.w = cvt_pk_bf16(q1[2], q1[3]); *(PG8_GAS u32x4*)(ob + opo + 96) = w; } }
        else {
#pragma unroll
            for (int ai = 0; ai < 2; ++ai)
#pragma unroll
                for (int m = 0; m < 4; ++m) { const int row = row0 + ai * HALF + m * 16; const unsigned ro = ((unsigned)row * (unsigned)ldc + (unsigned)col0) * 2u; const f32x2s mr = row_mr(lp, prow0 + ai * HALF + m * 16); const float mu = mr.x, r = mr.y;
#pragma unroll
                    for (int bj = 0; bj < 2; ++bj) { const float qr = (I8 ? qs : 1.0f) * r, mur = mu * r;
                        const f32x4 v0 = cv(acc[ai][bj][m][0]) * qr + (a2[bj][0] - a1[bj][0] * mur), v1 = cv(acc[ai][bj][m][1]) * qr + (a2[bj][1] - a1[bj][1] * mur);
                        u32x4 w; w.x = cvt_pk_bf16(v0[0], v0[1]); w.y = cvt_pk_bf16(v0[2], v0[3]); w.z = cvt_pk_bf16(v1[0], v1[1]); w.w = cvt_pk_bf16(v1[2], v1[3]);
                        *(PG8_GAS u32x4*)(ob + ro + bj * (HALF * 2)) = w; } } }
    }
};
struct SplitOrder : StaticOrder {
    const PG8_LAS int* pe; int pm0, npt;
    __device__ __forceinline__ bool next(int i, Unit& u) const { const long x = (long)i * G + c; if (x >= (long)npt * 28) return false;
        const int t = (int)x / 28, rm = (int)x - t * 28; u.pm = pm0 + t; u.pn = rm / 7; u.job = rm - u.pn * 7; return true; }
    __device__ __forceinline__ const char* a_ptr(const Gemm& g, const Unit& u, size_t) const { return (const char*)g.A + u.job * 512; }
    __device__ __forceinline__ const char* b_ptr(const Gemm& g, const Unit& u, size_t tstep) const { return (const char*)g.Bt + (size_t)(pe[u.pm] * 4 + u.pn) * tstep + u.job * 512; }
    __device__ __forceinline__ int row_token(const Unit& u, int r) const { unsigned idx = (unsigned)(u.pm * BM + r); asm volatile("" : "+v"(idx)); return (int)idx; }
};
struct EpiPart {
    static constexpr bool PERM = false, AFTER_DRAIN = false;
    float* P; int pm0;
    __device__ __forceinline__ void operator()(const f32x4 (&acc)[2][2][4][2], const Unit& u, int wr, int wc, int fr, int fq) const {
        int row0 = (u.job * 8 + (u.pm - pm0)) * BM + wr * 64 + fr; int col0 = u.pn * BM + wc * 32 + 4 * fq; asm volatile("" : "+v"(row0), "+v"(col0));
#pragma unroll
        for (int ai = 0; ai < 2; ++ai)
#pragma unroll
            for (int m = 0; m < 4; ++m) { float* rowp = P + (size_t)(row0 + ai * HALF + m * 16) * 1024 + col0;
#pragma unroll
                for (int bj = 0; bj < 2; ++bj)
#pragma unroll
                    for (int n = 0; n < 2; ++n) *(f32x4*)(rowp + bj * HALF + n * 16) = acc[ai][bj][m][n]; }
    }
};
struct P1Order : StaticOrder {
    const bf16_t* memb; const bf16_t* wkv;
    __device__ __forceinline__ bool next(int i, Unit& u) const {
        if (StaticOrder::next(i, u)) return true;
        const long x = (long)i * G + c - nwg; if (x < 0 || x >= 8) return false;
        u.job = 1 + (int)(x >> 2); u.pm = u.job == 1 ? (int)(x & 3) : 0; u.pn = u.job == 1 ? 0 : (int)(x & 3); return true; }
    __device__ __forceinline__ const char* a_ptr(const Gemm& g, const Unit& u, size_t tstep) const { return u.job == 0 ? (const char*)g.A + (size_t)u.pm * tstep : (u.job == 1 ? (const char*)memb + (size_t)u.pm * tstep : (const char*)wkv + tstep); }
    __device__ __forceinline__ const char* b_ptr(const Gemm& g, const Unit& u, size_t tstep) const { return u.job == 0 ? (const char*)g.Bt + (size_t)u.pn * tstep : (u.job == 1 ? (const char*)wkv : (const char*)memb + (size_t)u.pn * tstep); }
};
struct EpiP1 {
    static constexpr bool PERM = true, AFTER_DRAIN = false;
    bf16_t* H0; bf16_t* MK; bf16_t* MVT;
    __device__ __forceinline__ void operator()(const f32x4 (&acc)[2][2][4][2], const Unit& u, int wr, int wc, int fr, int fq) const {
        bf16_t* O = u.job == 0 ? H0 : (u.job == 1 ? MK : MVT); const int ldc = u.job == 0 ? 1792 : (u.job == 1 ? 256 : 1024);
        int row0 = u.pm * BM + wr * 64 + fr; int col0 = u.pn * BM + wc * 32 + 8 * fq; asm volatile("" : "+v"(row0), "+v"(col0));
        const PG8_GAS char* ob = (const PG8_GAS char*)O; const unsigned off0 = ((unsigned)row0 * (unsigned)ldc + (unsigned)col0) * 2u, dstep = (unsigned)ldc * 32u;
        const bool act = u.job == 0 && u.pn < 6;
#pragma unroll
        for (int ai = 0; ai < 2; ++ai)
#pragma unroll
            for (int m = 0; m < 4; ++m) { const unsigned off = off0 + (unsigned)(ai * 8 + m) * dstep;
#pragma unroll
                for (int bj = 0; bj < 2; ++bj) { f32x4 v0 = acc[ai][bj][m][0], v1 = acc[ai][bj][m][1];
                    if (act) { f32x2 a = gelu_pk((f32x2){v0[0], v0[1]}), b = gelu_pk((f32x2){v0[2], v0[3]}), c = gelu_pk((f32x2){v1[0], v1[1]}), d = gelu_pk((f32x2){v1[2], v1[3]});
                        v0 = (f32x4){a.x, a.y, b.x, b.y}; v1 = (f32x4){c.x, c.y, d.x, d.y}; }
                    u32x4 w; w.x = cvt_pk_bf16(v0[0], v0[1]); w.y = cvt_pk_bf16(v0[2], v0[3]); w.z = cvt_pk_bf16(v1[0], v1[1]); w.w = cvt_pk_bf16(v1[2], v1[3]);
                    *(PG8_GAS u32x4*)(ob + off + bj * (HALF * 2)) = w; } }
    }
};
struct MoeOrder : StaticOrder {
    const PG8_LAS int* pe; int nbt; const int* rowtok;
    __device__ __forceinline__ const char* a_ptr(const Gemm& g, const Unit&, size_t) const { return (const char*)g.A; }
    __device__ __forceinline__ int row_token(const Unit& u, int r) const { unsigned idx = (unsigned)(u.pm * BM + r); asm volatile("" : "+v"(idx)); return rowtok ? rowtok[idx] : (int)idx; }
    __device__ __forceinline__ const char* b_ptr(const Gemm& g, const Unit& u, size_t tstep) const { return (const char*)g.Bt + (size_t)(pe[u.pm] * nbt + u.pn) * tstep; }
};
template <class T, class = void> struct epi_rep { static constexpr bool value = false; };
template <class T> struct epi_rep<T, decltype((void)T::REP)> { static constexpr bool value = true; };
template <class Epi, class Sched, bool ALIGN_EPI = false, bool SP2 = false, int FP8 = 0  , bool GATHER = false>
__device__ __forceinline__ void gemm_phase(PG8_LAS unsigned char* lds, const Gemm g, const Sched& S, const Epi& E, const int wave_id  ) {
    int tid = wave_id * 64 + (int)__builtin_amdgcn_mbcnt_hi(~0u, __builtin_amdgcn_mbcnt_lo(~0u, 0u)); asm volatile("" : "+v"(tid));
    const int wid = wave_id, lane = tid & 63, wr = wid >> 2, wc = wid & 3, fr = lane & 15, fq = lane >> 4;
    const int K = g.K, nt = K / BK, LD = g.ld ? g.ld : g.K;
    unsigned voffA[2], voffB[2];
#pragma unroll
    for (int i = 0; i < 2; ++i) { int R, C; stage_rc(tid * 16 + i * 8192, R, C); const int Rb = Epi::PERM ? ((R & ~31) + perm32(R & 31)) : R;
        voffA[i] = (unsigned)(R * LD + C) * 2u; voffB[i] = (unsigned)(Rb * LD + C) * 2u; }
    static_assert(SP2 || !GATHER, "GATHER needs the SP2 loop");
    unsigned goff[2][2], ngoff[2][2];
#define PG8_GOFF(dst, unit) do { _Pragma("unroll") for (int _h = 0; _h < 2; ++_h) _Pragma("unroll") for (int _i = 0; _i < 2; ++_i) { int _R, _C; stage_rc(tid * 16 + _i * 8192, _R, _C); \
        dst[_h][_i] = (unsigned)S.row_token(unit, _h * HALF + _R) * (unsigned)(LD * 2) + (unsigned)(_C * 2); } } while (0)
    const size_t kstep = (size_t)(BK * 2);
    const size_t hstep = (size_t)HALF * LD * 2;
    const size_t ahstep = GATHER ? (size_t)0 : hstep;
    const size_t tstep = 2 * hstep;
    const unsigned ldsw = (unsigned)wid * 1024u;
    const int aoff = lds_byte(wr * 64 + fr, fq * 8), boff = lds_byte(wc * 32 + fr, fq * 8);
#define PG8_SA(b, h) (((b) * 2 + (h)) * HTB)
#define PG8_SB(b, h) ((4 + (b) * 2 + (h)) * HTB)
#define PG8_STAGE(bufoff, gbase, voff) do { _Pragma("unroll") for (int _i = 0; _i < 2; ++_i) { unsigned _vo = (voff)[_i]; asm volatile("" : "+v"(_vo)); const PG8_GAS char* _gb = (const PG8_GAS char*)(gbase); asm volatile("" : "+s"(_gb));     \
        __builtin_amdgcn_global_load_lds((const PG8_GAS unsigned*)(_gb + _vo), (PG8_LAS unsigned*)(lds + (bufoff) + ldsw + _i * 8192), 16, 0, 0); } } while (0)
#define PG8_STAGE_A(bufoff, gbase, h) do { if constexpr (GATHER) PG8_STAGE(bufoff, gbase, goff[h]); else PG8_STAGE(bufoff, gbase, voffA); } while (0)
#define PG8_LDA(dst, b, h) do { _Pragma("unroll") for (int m = 0; m < 4; ++m) _Pragma("unroll") for (int k = 0; k < 2; ++k) dst[m][k] = *(const PG8_LAS bf16x8*)(lds + PG8_SA(b, h) + aoff + m * 2048 + k * 1024); } while (0)
#define PG8_LDB(dst, b, h) do { _Pragma("unroll") for (int n = 0; n < 2; ++n) _Pragma("unroll") for (int k = 0; k < 2; ++k) dst[n][k] = *(const PG8_LAS bf16x8*)(lds + PG8_SB(b, h) + boff + n * 2048 + k * 1024); } while (0)
#define PG8_CAT8(x) __builtin_shufflevector(__builtin_bit_cast(i32x4, (x)[0]), __builtin_bit_cast(i32x4, (x)[1]), 0, 1, 2, 3, 4, 5, 6, 7)
#define PG8_MMA(ai, bj, At, Bt) do { __builtin_amdgcn_s_setprio(1); if constexpr (FP8 == 1) { _Pragma("unroll") for (int m = 0; m < 4; ++m) _Pragma("unroll") for (int n = 0; n < 2; ++n) _Pragma("unroll") for (int k = 0; k < 2; ++k) \
        acc[ai][bj][m][n] = __builtin_bit_cast(f32x4, __builtin_amdgcn_mfma_i32_16x16x64_i8(__builtin_bit_cast(i32x4, Bt[n][k]), __builtin_bit_cast(i32x4, At[m][k]), __builtin_bit_cast(i32x4, acc[ai][bj][m][n]), 0, 0, 0)); } else if constexpr (FP8 != 0) { _Pragma("unroll") for (int m = 0; m < 4; ++m) _Pragma("unroll") for (int n = 0; n < 2; ++n) \
        acc[ai][bj][m][n] = __builtin_amdgcn_mfma_scale_f32_16x16x128_f8f6f4(PG8_CAT8(Bt[n]), PG8_CAT8(At[m]), acc[ai][bj][m][n], 0, 0, 0, FP8 * 0x01010101, 0, 0x7F7F7F7F); } else { \
        _Pragma("unroll") for (int m = 0; m < 4; ++m) _Pragma("unroll") for (int n = 0; n < 2; ++n) _Pragma("unroll") for (int k = 0; k < 2; ++k) \
        acc[ai][bj][m][n] = __builtin_amdgcn_mfma_f32_16x16x32_bf16(Bt[n][k], At[m][k], acc[ai][bj][m][n], 0, 0, 0); } __builtin_amdgcn_s_setprio(0); } while (0)
#define PG8_WR() ({ int w_ = wave_id; asm volatile("" : "+s"(w_)); w_ >> 2; })
#define PG8_WAIT_V(n) asm volatile("s_waitcnt vmcnt(" #n ")" ::: "memory")
#define PG8_WAIT_L(n) asm volatile("s_waitcnt lgkmcnt(" #n ")" ::: "memory")
#define PG8_BAR __builtin_amdgcn_s_barrier()
#define PG8_SCHED __builtin_amdgcn_sched_barrier(0)
    Unit cur, nxt; int ui = 0;
    if (!S.next(0, cur)) return;
    f32x4 acc[2][2][4][2];
#define PG8_ZACC() do { _Pragma("unroll") for (int a_ = 0; a_ < 2; ++a_) _Pragma("unroll") for (int b_ = 0; b_ < 2; ++b_) _Pragma("unroll") for (int m_ = 0; m_ < 4; ++m_) _Pragma("unroll") for (int n_ = 0; n_ < 2; ++n_) { \
        typedef unsigned long long u64x2_ __attribute__((ext_vector_type(2))); u64x2_ z_; asm volatile("v_mov_b64 %0, 0" : "=v"(z_.x)); asm volatile("v_mov_b64 %0, 0" : "=v"(z_.y)); acc[a_][b_][m_][n_] = __builtin_bit_cast(f32x4, z_); } } while (0)
    PG8_ZACC();
    bf16x8 At[4][2], B0[2][2], B1[2][2];
    const char* cA = S.a_ptr(g, cur, tstep); const char* cB = S.b_ptr(g, cur, tstep);
    S.a_ready(cur);
    if constexpr (GATHER) PG8_GOFF(goff, cur);
    if constexpr (SP2) {
        PG8_STAGE(PG8_SB(0, 0), cB, voffB); PG8_STAGE(PG8_SB(0, 1), cB + hstep, voffB); PG8_STAGE_A(PG8_SA(0, 0), cA, 0); PG8_STAGE_A(PG8_SA(0, 1), cA + ahstep, 1);
        if (PG8_WR() == 1) PG8_BAR;
        PG8_WAIT_V(2); PG8_BAR;
        PG8_STAGE(PG8_SB(1, 0), cB + kstep, voffB); PG8_STAGE_A(PG8_SA(1, 0), cA + kstep, 0); PG8_STAGE(PG8_SB(1, 1), cB + hstep + kstep, voffB);
        PG8_WAIT_V(6); PG8_BAR;
    } else {
        PG8_STAGE(PG8_SB(0, 0), cB, voffB); PG8_STAGE(PG8_SA(0, 0), cA, voffA); PG8_STAGE(PG8_SB(0, 1), cB + hstep, voffB); PG8_STAGE(PG8_SA(0, 1), cA + hstep, voffA);
        if (PG8_WR() == 1) PG8_BAR;
        PG8_WAIT_V(4); PG8_BAR;
        PG8_STAGE(PG8_SB(1, 0), cB + kstep, voffB); PG8_STAGE(PG8_SA(1, 0), cA + kstep, voffA); PG8_STAGE(PG8_SB(1, 1), cB + hstep + kstep, voffB);
        PG8_WAIT_V(6); PG8_BAR;
    }
    for (;;) {
        const bool has_next = S.next(ui + 1, nxt);
        const char* nA = has_next ? S.a_ptr(g, nxt, tstep) : cA; const char* nB = has_next ? S.b_ptr(g, nxt, tstep) : cB;
        const bool regather = GATHER && has_next && nxt.pm != cur.pm;
        if constexpr (GATHER) { if (regather) PG8_GOFF(ngoff, nxt); }
#pragma nounroll
        for (int t = 0; t < nt; t += 2) {
            const bool last = (t == nt - 2);
            const char* a1 = cA + (size_t)(t + 1) * kstep;
            const char* a2 = last ? nA : cA + (size_t)(t + 2) * kstep; const char* b2 = last ? nB : cB + (size_t)(t + 2) * kstep;
            const char* a3 = a2 + kstep; const char* b3 = b2 + kstep;
            if (last && has_next) S.a_ready(nxt);
            if constexpr (SP2) {
            PG8_LDB(B0, 0, 0); PG8_LDB(B1, 0, 1); PG8_SCHED; PG8_LDA(At, 0, 0); PG8_STAGE_A(PG8_SA(1, 1), a1 + ahstep, 1);
            if constexpr (GATHER) { if (last && regather) { goff[0][0] = ngoff[0][0]; goff[0][1] = ngoff[0][1]; goff[1][0] = ngoff[1][0]; goff[1][1] = ngoff[1][1]; } }
            PG8_WAIT_V(8); PG8_WAIT_L(0); PG8_BAR; PG8_MMA(0, 0, At, B0); PG8_MMA(0, 1, At, B1); PG8_BAR; PG8_SCHED;
            PG8_LDA(At, 0, 1); PG8_STAGE(PG8_SB(0, 0), b2, voffB); PG8_STAGE(PG8_SB(0, 1), b2 + hstep, voffB); PG8_STAGE_A(PG8_SA(0, 0), a2, 0);
            PG8_WAIT_V(8); PG8_WAIT_L(0); PG8_BAR; PG8_MMA(1, 0, At, B0); PG8_MMA(1, 1, At, B1); PG8_BAR; PG8_SCHED;
            PG8_LDB(B0, 1, 0); PG8_LDB(B1, 1, 1); PG8_SCHED; PG8_LDA(At, 1, 0); PG8_STAGE_A(PG8_SA(0, 1), a2 + ahstep, 1);
            PG8_WAIT_V(8); PG8_WAIT_L(0); PG8_BAR; PG8_MMA(0, 0, At, B0); PG8_MMA(0, 1, At, B1); PG8_BAR; PG8_SCHED;
            PG8_LDA(At, 1, 1); PG8_STAGE(PG8_SB(1, 0), b3, voffB); PG8_STAGE(PG8_SB(1, 1), b3 + hstep, voffB); PG8_STAGE_A(PG8_SA(1, 0), a3, 0);
            PG8_WAIT_V(8); PG8_WAIT_L(0); PG8_BAR; PG8_MMA(1, 0, At, B0); PG8_MMA(1, 1, At, B1); PG8_BAR; PG8_SCHED;
            } else {
            PG8_LDB(B0, 0, 0); PG8_SCHED; PG8_LDA(At, 0, 0); PG8_STAGE(PG8_SA(1, 1), a1 + hstep, voffA);
            PG8_WAIT_L(8); PG8_BAR; PG8_WAIT_L(0); PG8_MMA(0, 0, At, B0); PG8_BAR; PG8_SCHED;
            PG8_LDB(B1, 0, 1); PG8_STAGE(PG8_SB(0, 0), b2, voffB);
            PG8_BAR; PG8_WAIT_L(0); PG8_MMA(0, 1, At, B1); PG8_BAR;
            PG8_LDA(At, 0, 1); PG8_STAGE(PG8_SA(0, 0), a2, voffA);
            PG8_BAR; PG8_WAIT_L(0); PG8_MMA(1, 0, At, B0); PG8_BAR; PG8_SCHED;
            PG8_STAGE(PG8_SB(0, 1), b2 + hstep, voffB);
            PG8_WAIT_V(6); PG8_BAR; PG8_MMA(1, 1, At, B1); PG8_BAR;
            PG8_LDB(B0, 1, 0); PG8_SCHED; PG8_LDA(At, 1, 0); PG8_STAGE(PG8_SA(0, 1), a2 + hstep, voffA);
            PG8_WAIT_L(8); PG8_BAR; PG8_WAIT_L(0); PG8_MMA(0, 0, At, B0); PG8_BAR; PG8_SCHED;
            PG8_LDB(B1, 1, 1); PG8_STAGE(PG8_SB(1, 0), b3, voffB);
            PG8_BAR; PG8_WAIT_L(0); PG8_MMA(0, 1, At, B1); PG8_BAR;
            PG8_LDA(At, 1, 1); PG8_STAGE(PG8_SA(1, 0), a3, voffA);
            PG8_BAR; PG8_WAIT_L(0); PG8_MMA(1, 0, At, B0); PG8_BAR; PG8_SCHED;
            PG8_STAGE(PG8_SB(1, 1), b3 + hstep, voffB);
            PG8_WAIT_V(6); PG8_BAR; PG8_MMA(1, 1, At, B1); PG8_BAR;
            }
        }
        if constexpr (ALIGN_EPI) { if (PG8_WR() == 0) PG8_BAR; }
        if constexpr (!Epi::AFTER_DRAIN) { E(acc, cur, wr, wc, fr, fq);
#if REP_EPI
            if constexpr (epi_rep<Epi>::value) { if constexpr ((Epi::REP & REP_EPI) != 0) { __builtin_amdgcn_s_barrier(); E(acc, cur, wr, wc, fr, fq); } }
#endif
            S.done(cur); }
        if (!has_next) break;
        PG8_ZACC();
        cur = nxt; cA = nA; cB = nB; ++ui;
        if constexpr (ALIGN_EPI) { if (PG8_WR() == 1) PG8_BAR; }
    }
    PG8_WAIT_V(0);
    if constexpr (!ALIGN_EPI) { if (PG8_WR() == 0) PG8_BAR; }
    PG8_BAR;
    if constexpr (Epi::AFTER_DRAIN) { E.fused(acc, cur, wr, wc, fr, fq, lds, wid, lane); S.done(cur); }
#undef PG8_SA
#undef PG8_SB
#undef PG8_STAGE
#undef PG8_LDA
#undef PG8_STAGE_A
#undef PG8_LDB
#undef PG8_MMA
#undef PG8_GOFF
#undef PG8_CAT8
#undef PG8_WAIT_V
#undef PG8_WR
#undef PG8_WAIT_L
#undef PG8_BAR
#undef PG8_SCHED
}
}
#define PG8_SP2 true
#define PG8_ALIGN true
constexpr int NWAVES = 8;
#ifndef MK_SINGLE
#define MK_SINGLE 1
#endif

constexpr int BATCH = 4, SEQ = 8192, DM = 1024, NTOK = BATCH * SEQ;
constexpr int MIXW = 768, MEMW = 256, NMEM = 256;
constexpr int NINA = 2 * MIXW + MEMW;
constexpr int QKW = 384, NINB = 2 * QKW + 2 * MIXW + MEMW;
constexpr int DFF = 2816, DFFE = 3584, NEXP = 8;
constexpr int PASS_PANELS = 128, MAX_PANELS = 264, MAX_PASSES = 2;
constexpr float LN_EPS = 1e-5f, ALPHA = 1.41421356237f;

constexpr size_t MiB = 1u << 20, KiB = 1u << 10;
constexpr size_t WS_CTL = 0, CTL_ZERO_BYTES = 1 * MiB;
constexpr size_t WS_ROPEC = 1 * MiB, WS_ROPES = 2 * MiB + 512 * KiB;
constexpr size_t WS_MEMK = 4 * MiB, WS_MEMVT = 4 * MiB + 512 * KiB;
constexpr size_t WS_SGWB = 5 * MiB;
constexpr size_t WS_TOPI = 5 * MiB + 256 * KiB, WS_GATE = 5 * MiB + 512 * KiB, WS_DEST = 5 * MiB + 768 * KiB, WS_ROWTOK = 6 * MiB;
constexpr size_t WS_PRM = 6 * MiB + 512 * KiB;
constexpr size_t WS_MEMB = 7 * MiB, WS_WMKV = 9 * MiB;
constexpr size_t WS_WINA = 10 * MiB, WS_WINB = WS_WINA + 3 * MiB + 512 * KiB, WS_WOUT = WS_WINB + 5 * MiB, WS_WFFGU = WS_WOUT + 4 * MiB, WS_WFFD = WS_WFFGU + 11 * MiB,
                 WS_WEGU = WS_WFFD + 5 * MiB + 512 * KiB, WS_WED = WS_WEGU + 112 * MiB, WS_ACT = WS_WED + 56 * MiB;
static_assert(WS_ACT == 207 * MiB, "weights map");
constexpr size_t WS_XB = WS_ACT, WS_H0 = WS_ACT + 64 * MiB, WS_CAT0 = WS_ACT + 176 * MiB, WS_X1 = WS_ACT + 240 * MiB;
constexpr size_t WS_HID = WS_ACT, WS_X2 = WS_ACT + 176 * MiB;
constexpr size_t WS_H1 = WS_ACT, WS_CAT1 = WS_ACT + 240 * MiB;
constexpr size_t WS_X3 = WS_ACT, WS_X3Q = WS_ACT + 64 * MiB, WS_YR = WS_ACT + 96 * MiB;
constexpr size_t WS_PARTY = WS_ACT + 232 * MiB;
constexpr size_t WS_END = WS_ACT + 304 * MiB;
static_assert(WS_YR + (size_t)MAX_PANELS * 256 * DM * 2 <= WS_PARTY && WS_PARTY + (size_t)7 * 2048 * DM * 4 <= WS_END, "split-K slabs");
static_assert(WS_YR + (size_t)MAX_PANELS * 256 * DM * 2 <= WS_END && WS_HID + (size_t)NTOK * DFF * 2 <= WS_X2 && WS_H1 + (size_t)NTOK * NINB * 2 <= WS_CAT1, "d_ws map");
constexpr size_t DO_ST1 = 96 * MiB, DO_ST2 = 98 * MiB;
constexpr size_t DO_PART = 104 * MiB, DO_C1 = 106 * MiB, DO_C2 = 106 * MiB + 64 * KiB;
constexpr int NCV = 2 * 2816 + 2560;
constexpr size_t DO_ZQ = 0;
constexpr float HQ_SCALE = 16.0f, WD_SCALE = 3000.0f;
constexpr float WQ_SCALE = 1000.0f, ZQ_SCALE = 20.0f;
constexpr int CW_TMO = 0, CW_CODE = 1;
constexpr int CW_BAR = 4096;
constexpr int CW_HIST = 16384;
constexpr int CW_NP = 20480;
constexpr int CW_PE = 20544;

constexpr int RING_OFF = 0, RING_BYTES = 131072;
constexpr int LDSCTL_OFF = RING_BYTES, MISC_OFF = LDSCTL_OFF + 320;
constexpr int EPIP_OFF = LDSCTL_OFF + 2048;
constexpr int LDS_BYTES = 147456;
static_assert(MISC_OFF + 128 <= LDS_BYTES && EPIP_OFF + 8192 + 2048 <= LDS_BYTES, "LDS map");
#define GAS __attribute__((address_space(1)))
#define LAS __attribute__((address_space(3)))
typedef unsigned short bf16;
typedef unsigned v4u __attribute__((ext_vector_type(4)));
typedef float f32x4 __attribute__((ext_vector_type(4)));
typedef short bf16x8 __attribute__((ext_vector_type(8)));
typedef GAS unsigned gu32;
typedef GAS unsigned long long gu64;
#define RLX_AGENT __ATOMIC_RELAXED, __HIP_MEMORY_SCOPE_AGENT
#define LDS_WAIT() asm volatile("s_waitcnt lgkmcnt(0)" ::: "memory")
#define VM_WAIT() asm volatile("s_waitcnt vmcnt(0)" ::: "memory")
#define LBAR() do { asm volatile("s_waitcnt lgkmcnt(0)" ::: "memory"); __builtin_amdgcn_s_barrier(); asm volatile("" ::: "memory"); } while (0)
__device__ __forceinline__ unsigned long long rt() { return __builtin_amdgcn_s_memrealtime(); }
__device__ __forceinline__ unsigned f2bf(float f) { unsigned u = __builtin_bit_cast(unsigned, f); return (u + 0x7fffu + ((u >> 16) & 1u)) >> 16; }
__device__ __forceinline__ unsigned pk2(float lo, float hi) { return f2bf(lo) | (f2bf(hi) << 16); }

#define XB_TMO      128
#define XB_XCNT(j)  (256  + 64 * (j))
#define XB_XSUB(j)  (1280 + 64 * (j))
#define XB_XGEN(j)  (2304 + 64 * (j))
#define XB_TOP      3328
#define XB_TOPGEN   3392
#define XCD_BAR_WORDS 3456
#define XB_SPIN_CAP (1u << 18)

__device__ __forceinline__ unsigned xb_ld(unsigned* p)              { return __hip_atomic_load(p, __ATOMIC_RELAXED, __HIP_MEMORY_SCOPE_AGENT); }
__device__ __forceinline__ unsigned xb_add(unsigned* p, unsigned v) { return __hip_atomic_fetch_add(p, v, __ATOMIC_RELAXED, __HIP_MEMORY_SCOPE_AGENT); }
__device__ __forceinline__ unsigned xb_xcc_id() { return (unsigned)__builtin_amdgcn_s_getreg((3 << 11) | 20) & 0xFu; }
#define XB_SPIN(cond, bar) do { unsigned _sp = 0; while (cond) { __builtin_amdgcn_s_sleep(1); \
    if ((++_sp & 255u) == 0u) { if (xb_ld(&(bar)[XB_TMO])) break; if (_sp > XB_SPIN_CAP) { atomicAdd(&(bar)[XB_TMO], 1u); break; } } } } while (0)

struct XcdBarrier {
    unsigned* bar; unsigned x;
    volatile LAS unsigned* st;
};

__device__ __forceinline__ XcdBarrier xcd_barrier_post(unsigned* bar, volatile LAS unsigned* st) {
    XcdBarrier b; b.bar = bar; b.x = xb_xcc_id(); b.st = st;
    if (threadIdx.x == 0) (void)xb_add(&bar[XB_XCNT(b.x)], 1u);
    return b;
}
__device__ __forceinline__ void xcd_barrier_complete(unsigned* bar, unsigned x, unsigned& nloc, unsigned& nx) {
    const unsigned G = gridDim.x * gridDim.y * gridDim.z;
    unsigned sum, cnt, mine, sp = 0u;
    for (;;) {
        sum = 0u; cnt = 0u; mine = 0u;
#pragma unroll
        for (unsigned j = 0; j < 16; ++j) { const unsigned c = xb_ld(&bar[XB_XCNT(j)]); sum += c; cnt += (c > 0u) ? 1u : 0u; mine = (j == x) ? c : mine; }
        if (sum == G) break;
        __builtin_amdgcn_s_sleep(1);
        if ((++sp & 255u) == 0u) { if (xb_ld(&bar[XB_TMO])) break; if (sp > XB_SPIN_CAP) { atomicAdd(&bar[XB_TMO], 1u); break; } }
    }
    nloc = mine > 0u ? mine : 1u; nx = cnt > 0u ? cnt : 1u;
}

__device__ __forceinline__ void xcd_barrier(const XcdBarrier& b) {
    asm volatile("s_waitcnt vmcnt(0)" ::: "memory");
    __syncthreads();
    if (threadIdx.x == 0) {
        unsigned* bar = b.bar;
        __builtin_amdgcn_s_waitcnt(0);
        unsigned nloc = b.st[0], nx = b.st[1];
        if (nloc == 0u) { xcd_barrier_complete(bar, b.x, nloc, nx); b.st[0] = nloc; b.st[1] = nx; }
        const unsigned old = xb_add(&bar[XB_XSUB(b.x)], 1u);
        const unsigned gen = old / nloc;
        if (old + 1u == (gen + 1u) * nloc) {
            __builtin_amdgcn_fence(__ATOMIC_RELEASE, "agent");
            asm volatile("s_waitcnt vmcnt(0)" ::: "memory");
            const unsigned og = xb_add(&bar[XB_TOP], 1u);
            const unsigned tg = og / nx;
            if (og + 1u == (tg + 1u) * nx) xb_add(&bar[XB_TOPGEN], 1u);
            else XB_SPIN(xb_ld(&bar[XB_TOPGEN]) == tg, bar);
            __builtin_amdgcn_fence(__ATOMIC_ACQUIRE, "agent");
            xb_add(&bar[XB_XGEN(b.x)], 1u);
            asm volatile("s_waitcnt vmcnt(0)" ::: "memory");
        } else {
            XB_SPIN(xb_ld(&bar[XB_XGEN(b.x)]) == gen, bar);
            __builtin_amdgcn_fence(__ATOMIC_ACQUIRE, "agent");
            asm volatile("s_waitcnt vmcnt(0)" ::: "memory");
        }
    }
    __syncthreads();
}
struct Frame {
    LAS unsigned char* lds;
    volatile LAS unsigned* MISC;
    gu32* ctl;
    int tid, lane, wave;
    int vcu, G;
};
struct Args { const float* in[24]; float* out; unsigned char* ws; int ph_lo, ph_hi, pass_lo, pass_hi, sub_lo, sub_hi, li, pad; };

typedef short bf16x4 __attribute__((ext_vector_type(4)));
using pg8::silu_f;
constexpr int PTR_OFF = LDSCTL_OFF + 1024;
__device__ __forceinline__ const float* inp(const Frame& F, int k) {
    const volatile LAS unsigned* p = (const volatile LAS unsigned*)(F.lds + PTR_OFF) + 2 * k;
    const unsigned lo = __builtin_amdgcn_readfirstlane(p[0]), hi = __builtin_amdgcn_readfirstlane(p[1]);
    return (const float*)(((unsigned long long)hi << 32) | lo);
}
typedef unsigned v2u __attribute__((ext_vector_type(2)));
__device__ __forceinline__ float wave_sum(float v) {
    return pg8::xsum32(pg8::xsum16(pg8::sum16(v)));
}
__device__ __forceinline__ float bflo(unsigned u) { return __uint_as_float(u << 16); }
__device__ __forceinline__ float bfhi(unsigned u) { return __uint_as_float(u & 0xffff0000u); }
__device__ __forceinline__ f32x4 mfma16(bf16x8 a, bf16x8 b, f32x4 c) { return __builtin_amdgcn_mfma_f32_16x16x32_bf16(a, b, c, 0, 0, 0); }
__device__ __forceinline__ bf16x8 lds_frag(const LAS unsigned char* p) { return *(const LAS bf16x8*)p; }
__device__ __forceinline__ bf16x8 lds_frag_split(const LAS unsigned char* lo, const LAS unsigned char* hi) {
    const bf16x4 a = *(const LAS bf16x4*)lo, b = *(const LAS bf16x4*)hi; return __builtin_shufflevector(a, b, 0, 1, 2, 3, 4, 5, 6, 7);
}
typedef short s16x4 __attribute__((ext_vector_type(4)));
__device__ __forceinline__ bf16x8 lds_frag_tr(const LAS unsigned char* blk, int pitch, int lane, int rows2 = 4  ) {
    const int q = (lane >> 2) & 3, p = lane & 3; const LAS unsigned char* a = blk + q * pitch + p * 8;
    const s16x4 lo = __builtin_amdgcn_ds_read_tr16_b64_v4i16((LAS s16x4*)a), hi = __builtin_amdgcn_ds_read_tr16_b64_v4i16((LAS s16x4*)(a + rows2 * pitch));
    return __builtin_bit_cast(bf16x8, __builtin_shufflevector(lo, hi, 0, 1, 2, 3, 4, 5, 6, 7));
}
__device__ __forceinline__ bf16x8 pack_frag(const f32x4& a, const f32x4& b) {
    v4u w; w.x = pk2(a[0], a[1]); w.y = pk2(a[2], a[3]); w.z = pk2(b[0], b[1]); w.w = pk2(b[2], b[3]); return __builtin_bit_cast(bf16x8, w);
}
__device__ __forceinline__ bf16x8 scale_frag(bf16x8 f, float s) {
    const v4u u = __builtin_bit_cast(v4u, f); v4u w;
    w.x = pk2(bflo(u.x) * s, bfhi(u.x) * s); w.y = pk2(bflo(u.y) * s, bfhi(u.y) * s); w.z = pk2(bflo(u.z) * s, bfhi(u.z) * s); w.w = pk2(bflo(u.w) * s, bfhi(u.w) * s);
    return __builtin_bit_cast(bf16x8, w);
}
#define PIN_OFF(o) asm volatile("" : "+v"(o))
__device__ __forceinline__ v4u gld16(const void* base, unsigned off) { PIN_OFF(off); return *(const GAS v4u*)((const GAS char*)base + off); }
__device__ __forceinline__ v2u gld8(const void* base, unsigned off) { PIN_OFF(off); return *(const GAS v2u*)((const GAS char*)base + off); }
__device__ __forceinline__ float gld4(const void* base, unsigned off) { PIN_OFF(off); return *(const GAS float*)((const GAS char*)base + off); }
__device__ __forceinline__ void gst8(void* base, unsigned off, unsigned long long v) { PIN_OFF(off); *(GAS unsigned long long*)((GAS char*)base + off) = v; }
__device__ __forceinline__ unsigned long long pk4(float a, float b, float c, float d) { return (unsigned long long)pk2(a, b) | ((unsigned long long)pk2(c, d) << 32); }
__device__ __forceinline__ void gst8x2(void* base, unsigned off, unsigned long long a, unsigned long long b, int quad) {
    const auto s0 = __builtin_amdgcn_permlane16_swap((unsigned)a, (unsigned)b, false, false), s1 = __builtin_amdgcn_permlane16_swap((unsigned)(a >> 32), (unsigned)(b >> 32), false, false);
    off += (quad & 1) ? 24u : 0u; PIN_OFF(off); *(GAS v4u*)((GAS char*)base + off) = (v4u){s0[0], s1[0], s0[1], s1[1]};
}

__device__ __forceinline__ void p0_transpose_item(const float* W, int K, int N, bf16* dst, LAS unsigned char* scr, int kb, int nb, int lane, const float* gk, const float* bk, float* part, int dg0, int dg1, int dg2, int dg3, float q8 = 0.f  ) {
    const int k0 = 64 * kb, n0 = 64 * nb, nq = lane & 15, kr = lane >> 4;
    f32x4 v[16];
#pragma unroll
    for (int i = 0; i < 16; ++i) v[i] = __builtin_nontemporal_load((const GAS f32x4*)(W + (size_t)(k0 + 16 * kr + i) * N + n0 + 4 * nq));
    if (gk) {
        f32x4 s1 = (f32x4){0.f, 0.f, 0.f, 0.f}, s2 = s1;
#pragma unroll
        for (int i4 = 0; i4 < 4; ++i4) { const f32x4 gg = *(const GAS f32x4*)(gk + k0 + 16 * kr + 4 * i4), bb = *(const GAS f32x4*)(bk + k0 + 16 * kr + 4 * i4);
#pragma unroll
            for (int j = 0; j < 4; ++j) { s2 += v[4 * i4 + j] * bb[j]; v[4 * i4 + j] = v[4 * i4 + j] * gg[j]; s1 += v[4 * i4 + j]; } }
#pragma unroll
        for (int c = 0; c < 4; ++c) { s1[c] = pg8::xsum32(pg8::xsum16(s1[c])); s2[c] = pg8::xsum32(pg8::xsum16(s2[c])); }
        if (kr == 0) { const int gsel = nq >> 2, dgr = gsel == 0 ? dg0 : (gsel == 1 ? dg1 : (gsel == 2 ? dg2 : dg3)); float* q = part + ((size_t)kb * NCV + dgr + (4 * nq & 15)) * 2; *(GAS f32x4*)q = (f32x4){s1[0], s2[0], s1[1], s2[1]}; *(GAS f32x4*)(q + 4) = (f32x4){s1[2], s2[2], s1[3], s2[3]}; } }
    if (q8 != 0.f) {
#pragma unroll
        for (int c = 0; c < 4; ++c) { v4u a;
            a.x = pg8::q8x4(v[0][c] * q8, v[1][c] * q8, v[2][c] * q8, v[3][c] * q8); a.y = pg8::q8x4(v[4][c] * q8, v[5][c] * q8, v[6][c] * q8, v[7][c] * q8);
            a.z = pg8::q8x4(v[8][c] * q8, v[9][c] * q8, v[10][c] * q8, v[11][c] * q8); a.w = pg8::q8x4(v[12][c] * q8, v[13][c] * q8, v[14][c] * q8, v[15][c] * q8);
            *(LAS v4u*)(scr + (c * 16 + nq) * 80 + kr * 16) = a; }
        LDS_WAIT(); asm volatile("" ::: "memory");
#pragma unroll
        for (int r = 0; r < 4; ++r) { const int id = lane + 64 * r, c4 = id & 3, rho = id >> 2, n = (rho & 15) * 4 + (rho >> 4), gsel = n >> 4;
            const int row = (gsel == 0 ? dg0 : (gsel == 1 ? dg1 : (gsel == 2 ? dg2 : dg3))) + (n & 15);
            *(GAS v4u*)((unsigned char*)dst + (size_t)row * K + k0 + 16 * c4) = *(const LAS v4u*)(scr + rho * 80 + c4 * 16); }
        LDS_WAIT(); asm volatile("" ::: "memory");
        return; }
#pragma unroll
    for (int c = 0; c < 4; ++c) { v4u a, b;
        a.x = pk2(v[0][c], v[1][c]); a.y = pk2(v[2][c], v[3][c]); a.z = pk2(v[4][c], v[5][c]); a.w = pk2(v[6][c], v[7][c]);
        b.x = pk2(v[8][c], v[9][c]); b.y = pk2(v[10][c], v[11][c]); b.z = pk2(v[12][c], v[13][c]); b.w = pk2(v[14][c], v[15][c]);
        LAS unsigned char* q = scr + (c * 16 + nq) * 144 + kr * 32; *(LAS v4u*)q = a; *(LAS v4u*)(q + 16) = b; }
    LDS_WAIT(); asm volatile("" ::: "memory");
#pragma unroll
    for (int r = 0; r < 8; ++r) { const int id = lane + 64 * r, c8 = id & 7, rho = id >> 3, n = (rho & 15) * 4 + (rho >> 4), gsel = n >> 4;
        const int row = (gsel == 0 ? dg0 : (gsel == 1 ? dg1 : (gsel == 2 ? dg2 : dg3))) + (n & 15);
        *(GAS v4u*)(dst + (size_t)row * K + k0 + 8 * c8) = *(const LAS v4u*)(scr + rho * 144 + c8 * 16); }
    LDS_WAIT(); asm volatile("" ::: "memory");
}
__device__ __forceinline__ unsigned pk_i8x4(float a, float b, float c, float d) { return pg8::q8x4(a, b, c, d); }
__device__ __forceinline__ unsigned pk_fp8x4(float a, float b, float c, float d) { int w = __builtin_amdgcn_cvt_pk_fp8_f32(a, b, 0, false); w = __builtin_amdgcn_cvt_pk_fp8_f32(c, d, w, true); return (unsigned)w; }
struct ExpHalf { const float* src; unsigned char* dst; int N, K, hh; float sc; bool i8; };
__device__ __forceinline__ bool exp_half(int q, int gw, int NGW, const float* wg, const float* wu, const float* wd, unsigned char* ws, ExpHalf& H) {
    const int it = gw + NGW * (q >> 1); if (it >= 24 * 448) return false;
    const int j = it / 448, r = it - j * 448, e = j & 7, kind = j >> 3; H.hh = q & 1;
    H.i8 = kind != 2;
    if (kind == 2) { const int kb = r >> 4, nb = r & 15; H.N = DM; H.K = DFFE; H.sc = 128.0f;
        H.src = wd + (size_t)e * DFFE * DM + (size_t)(128 * kb + 64 * H.hh) * DM + 64 * nb; H.dst = ws + WS_WED + ((size_t)e * DM + 64 * nb) * DFFE + 128 * kb; }
    else { const int kb = r / 56, nb = r - kb * 56, n0 = 64 * nb; H.N = DFFE; H.K = DM; H.sc = WQ_SCALE;
        H.src = (kind ? wu : wg) + (size_t)e * DM * DFFE + (size_t)(128 * kb + 64 * H.hh) * DFFE + n0;
        H.dst = ws + WS_WEGU + ((size_t)e * 2 * DFFE + (n0 >> 7) * 256 + (n0 & 127) + (kind ? 128 : 0)) * DM + 128 * kb; }
    return true;
}
__device__ __forceinline__ void exp_load(f32x4 (&v)[16], const ExpHalf& H, int lane) {
    const int nq = lane & 15, kr = lane >> 4;
#pragma unroll
    for (int i = 0; i < 16; ++i) v[i] = __builtin_nontemporal_load((const GAS f32x4*)(H.src + (size_t)(16 * kr + i) * H.N + 4 * nq));
}
__device__ __forceinline__ void exp_process(const f32x4 (&v)[16], const ExpHalf& H, LAS unsigned char* scr, int lane) {
    const int nq = lane & 15, kr = lane >> 4;
#pragma unroll
    for (int c = 0; c < 4; ++c) { v4u a;
        if (H.i8) { a.x = pk_i8x4(v[0][c] * H.sc, v[1][c] * H.sc, v[2][c] * H.sc, v[3][c] * H.sc); a.y = pk_i8x4(v[4][c] * H.sc, v[5][c] * H.sc, v[6][c] * H.sc, v[7][c] * H.sc);
            a.z = pk_i8x4(v[8][c] * H.sc, v[9][c] * H.sc, v[10][c] * H.sc, v[11][c] * H.sc); a.w = pk_i8x4(v[12][c] * H.sc, v[13][c] * H.sc, v[14][c] * H.sc, v[15][c] * H.sc); }
        else { a.x = pk_fp8x4(v[0][c] * H.sc, v[1][c] * H.sc, v[2][c] * H.sc, v[3][c] * H.sc); a.y = pk_fp8x4(v[4][c] * H.sc, v[5][c] * H.sc, v[6][c] * H.sc, v[7][c] * H.sc);
            a.z = pk_fp8x4(v[8][c] * H.sc, v[9][c] * H.sc, v[10][c] * H.sc, v[11][c] * H.sc); a.w = pk_fp8x4(v[12][c] * H.sc, v[13][c] * H.sc, v[14][c] * H.sc, v[15][c] * H.sc); }
        *(LAS v4u*)(scr + (c * 16 + nq) * 144 + H.hh * 64 + kr * 16) = a; }
    if (H.hh == 1) { LDS_WAIT(); asm volatile("" ::: "memory");
#pragma unroll
        for (int r = 0; r < 8; ++r) { const int id = lane + 64 * r, c8 = id & 7, rho = id >> 3, n = (rho & 15) * 4 + (rho >> 4);
            *(GAS v4u*)(H.dst + (size_t)n * H.K + 16 * c8) = *(const LAS v4u*)(scr + rho * 144 + c8 * 16); }
        LDS_WAIT(); asm volatile("" ::: "memory"); }
}
__device__ __forceinline__ void rows_load(f32x4 (&v)[16], const float* src, int m, int lane) {
#pragma unroll
    for (int r = 0; r < 4; ++r)
#pragma unroll
        for (int j = 0; j < 4; ++j) v[4 * r + j] = __builtin_nontemporal_load((const GAS f32x4*)(src + (size_t)(m + r) * DM) + lane + 64 * j);
}
__device__ __forceinline__ void rows_store(const f32x4 (&v)[16], bf16* dst, int m, int lane) {
#pragma unroll
    for (int r = 0; r < 4; ++r)
#pragma unroll
        for (int j = 0; j < 4; ++j) ((GAS unsigned long long*)(dst + (size_t)(m + r) * DM))[lane + 64 * j] = pk4(v[4 * r + j].x, v[4 * r + j].y, v[4 * r + j].z, v[4 * r + j].w);
}
__device__ __forceinline__ void p0_rows_to_bf16(const float* src, bf16* dst, int nrows, int gw, int NGW, int lane) {
    f32x4 va[16], vb[16]; int m = 4 * gw; const int st = 4 * NGW;
    if (m < nrows) rows_load(va, src, m, lane);
    for (; m < nrows; m += 2 * st) {
        if (m + st < nrows) rows_load(vb, src, m + st, lane);
        rows_store(va, dst, m, lane);
        if (m + 2 * st < nrows) rows_load(va, src, m + 2 * st, lane);
        if (m + st < nrows) rows_store(vb, dst, m + st, lane); }
}
__device__ __forceinline__ void p0_prologue(Frame& F, const Args& A) {
    unsigned char* ws = A.ws;
    const float* const in0 = inp(F, 0); const float* const in1 = inp(F, 1); const float* const in2 = inp(F, 2); const float* const in3 = inp(F, 3); const float* const in6 = inp(F, 6); const float* const in8 = inp(F, 8);
    const float* const lng_ = inp(F, 14); const float* const lnb_ = inp(F, 15);
    const float* const in13 = inp(F, 13); const float* const in16 = inp(F, 16); const float* const in17 = inp(F, 17); const float* const in18 = inp(F, 18); const float* const in21 = inp(F, 21); const float* const in22 = inp(F, 22); const float* const in23 = inp(F, 23);
    LAS unsigned char* scr = F.lds + RING_OFF + F.wave * 16384;
    const int gw = F.vcu * NWAVES + F.wave, NGW = F.G * NWAVES;
    const int gt = F.vcu * (NWAVES * 64) + F.tid, NGT = F.G * NWAVES * 64;
    constexpr int I_INA = 16 * 28, I_INB = 16 * 40, I_OUT = 16 * 16, I_FF = 16 * 44, I_FFD = 44 * 16, I_MKV = 16 * 8, I_EX = 896, I_EX8 = 448;
    constexpr int NSMALL = I_INA + I_INB + 2 * I_OUT + 2 * I_FF + I_FFD + I_MKV;
    for (int it = gw; it < NSMALL; it += NGW) {
        int r = it; const float* src; bf16* dst; int K, N, kind = 0, fold = 0; float q8 = 0.f;
        if (r < I_INA) { src = in3; dst = (bf16*)(ws + WS_WINA); K = DM; N = NINA; }
        else if ((r -= I_INA) < I_INB) { src = in8; dst = (bf16*)(ws + WS_WINB); K = DM; N = NINB; fold = 2; }
        else if ((r -= I_INB) < 2 * I_OUT) { const int l = r / I_OUT; r -= l * I_OUT; src = in13 + (size_t)l * DM * DM; dst = (bf16*)(ws + WS_WOUT) + (size_t)l * DM * DM; K = DM; N = DM; }
        else if ((r -= 2 * I_OUT) < I_FF) { src = in16; dst = (bf16*)(ws + WS_WFFGU); K = DM; N = DFF; kind = 1; fold = 1; }
        else if ((r -= I_FF) < I_FF) { src = in17; dst = (bf16*)(ws + WS_WFFGU); K = DM; N = DFF; kind = 2; fold = 1; }
        else if ((r -= I_FF) < I_FFD) { src = in18; dst = (bf16*)(ws + WS_WFFD); K = DFF; N = DM; q8 = WD_SCALE; }
        else { r -= I_FFD; src = in2; dst = (bf16*)(ws + WS_WMKV); K = DM; N = 512; }
        const int nblk = N / 64, kb = r / nblk, nb = r % nblk, n0 = 64 * nb;
        const int drow = kind == 0 ? n0 : ((n0 >> 7) * 256 + (n0 & 127) + (kind == 2 ? 128 : 0));
        int dg[4];
#pragma unroll
        for (int gi = 0; gi < 4; ++gi) { dg[gi] = drow + 16 * gi;
            if (fold == 2 && n0 < 2 * QKW) { const int n = n0 + 16 * gi, hd = n / 96, d = n - hd * 96, pr = hd * 48 + (d >= 48 ? d - 48 : d);
                dg[gi] = (pr >> 7) * 256 + (d >= 48 ? 128 : 0) + (pr & 127); } }
        const float* gk = fold ? lng_ + (fold - 1) * DM : nullptr; const float* bk = lnb_ + (fold ? fold - 1 : 0) * DM;
        p0_transpose_item(src, K, N, dst, scr, kb, nb, F.lane, gk, bk, (float*)((unsigned char*)A.out + DO_PART) + (size_t)(fold == 2 ? 2 * DFF : 0) * 2, dg[0], dg[1], dg[2], dg[3], fold ? WQ_SCALE : q8);
    }
    { f32x4 va[16], vb[16]; ExpHalf Ha, Hb; int q = 0;
      bool oka = exp_half(q, gw, NGW, in21, in22, in23, ws, Ha); if (oka) exp_load(va, Ha, F.lane);
      while (oka) { const bool okb = exp_half(q + 1, gw, NGW, in21, in22, in23, ws, Hb); if (okb) exp_load(vb, Hb, F.lane);
          exp_process(va, Ha, scr, F.lane);
          oka = okb && exp_half(q + 2, gw, NGW, in21, in22, in23, ws, Ha); if (oka) exp_load(va, Ha, F.lane);
          if (okb) exp_process(vb, Hb, scr, F.lane);
          q += 2; } }
    p0_rows_to_bf16(in0, (bf16*)(ws + WS_XB), NTOK, gw, NGW, F.lane);
    p0_rows_to_bf16(in1, (bf16*)(ws + WS_MEMB), BATCH * NMEM, gw, NGW, F.lane);
    { const float* sgw = in6; bf16* SG = (bf16*)(ws + WS_SGWB);
      for (int i = gt; i < 8 * 128 * 128 / 4; i += NGT) { const f32x4 v = ((const GAS f32x4*)sgw)[i]; ((GAS unsigned long long*)SG)[i] = pk4(v.x, v.y, v.z, v.w); }
      float* rc = (float*)(ws + WS_ROPEC); float* rs = (float*)(ws + WS_ROPES);
      for (int i = gt; i < SEQ * 48; i += NGT) { const int pos = i / 48, k = i - pos * 48;
          const float inv = __builtin_amdgcn_exp2f(-((float)(2 * k) / 96.0f) * 13.287712379549449f);
          const float ang = (float)pos * inv;
          double rev = (double)ang * 0.15915494309189535; rev -= __builtin_rint(rev);
          rc[i] = __builtin_amdgcn_cosf((float)rev); rs[i] = __builtin_amdgcn_sinf((float)rev); }
      int* rowtok = (int*)(ws + WS_ROWTOK);
      for (int i = gt; i < MAX_PANELS * 256; i += NGT) rowtok[i] = 0;
      if (gt < 8) { const float lg = (gt < 4) ? inp(F, 9)[gt] : inp(F, 10)[gt - 4];
          const double ls = -log1p(exp(-(double)lg));
          ((float*)(ws + WS_PRM))[gt] = (float)(ls * 1.4426950408889634); }
    }
}

struct AttnRegs { v4u q[2], k[4], v[4]; };
__device__ __forceinline__ void attn_issue(AttnRegs& R, int tid, const bf16* qb, int ldq, int b, int hh, int t0, const bf16* MK, const bf16* MVT) {
#pragma unroll
    for (int i = 0; i < 2; ++i) { const int id = tid + 512 * i, row = id >> 3, ch = id & 7; R.q[i] = gld16(qb + (size_t)t0 * ldq, (unsigned)(row * ldq + ch * 8) * 2u); }
#pragma unroll
    for (int i = 0; i < 4; ++i) { const int id = tid + 512 * i, row = id >> 3, ch = id & 7; R.k[i] = gld16(MK + (size_t)b * 65536 + hh * 64, (unsigned)(row * 256 + ch * 8) * 2u); }
#pragma unroll
    for (int i = 0; i < 4; ++i) { const int id = tid + 512 * i, row = id >> 5, ch = id & 31; R.v[i] = gld16(MVT + (size_t)hh * 65536 + b * 256, (unsigned)(row * 1024 + ch * 8) * 2u); }
}
__device__ __forceinline__ void attn_commit(Frame& F, const AttnRegs& R) {
    LAS unsigned char* QS = F.lds + RING_OFF; LAS unsigned char* KS = QS + 128 * 144; LAS unsigned char* VT = KS + 256 * 144; const int tid = F.tid;
#pragma unroll
    for (int i = 0; i < 2; ++i) { const int id = tid + 512 * i, row = id >> 3, ch = id & 7; *(LAS v4u*)(QS + row * 144 + ch * 16) = R.q[i]; }
#pragma unroll
    for (int i = 0; i < 4; ++i) { const int id = tid + 512 * i, row = id >> 3, ch = id & 7; *(LAS v4u*)(KS + row * 144 + ch * 16) = R.k[i]; }
#pragma unroll
    for (int i = 0; i < 4; ++i) { const int id = tid + 512 * i, row = id >> 5, ch = id & 31; *(LAS v4u*)(VT + row * 528 + ch * 16) = R.v[i]; }
}
__device__ __forceinline__ void attn_compute(Frame& F, int t0, bf16* CAT, int ocol) {
    LAS unsigned char* QS = F.lds + RING_OFF; LAS unsigned char* KS = QS + 128 * 144; LAS unsigned char* VT = KS + 256 * 144;
    const int lane = F.lane, r16 = lane & 15, quad = lane >> 4, w = F.wave;
    f32x4 s[16];
#pragma unroll
    for (int mt = 0; mt < 16; ++mt) s[mt] = (f32x4){0.f, 0.f, 0.f, 0.f};
#pragma unroll
    for (int ks = 0; ks < 2; ++ks) { const bf16x8 qf = lds_frag(QS + (16 * w + r16) * 144 + ks * 64 + quad * 16);
#pragma unroll
        for (int mh = 0; mh < 16; mh += 8) { bf16x8 fa_[8];
#pragma unroll
            for (int mt = 0; mt < 8; ++mt) fa_[mt] = lds_frag(KS + (16 * (mh + mt) + r16) * 144 + ks * 64 + quad * 16);
            __builtin_amdgcn_sched_barrier(0);
#pragma unroll
            for (int mt = 0; mt < 8; ++mt) s[mh + mt] = mfma16(fa_[mt], qf, s[mh + mt]);
            __builtin_amdgcn_sched_barrier(0); } }
    float mx = -3.0e38f;
#pragma unroll
    for (int mt = 0; mt < 16; ++mt) { mx = fmaxf(mx, fmaxf(fmaxf(s[mt][0], s[mt][1]), fmaxf(s[mt][2], s[mt][3]))); }
    mx = pg8::xmax32(pg8::xmax16(mx));
    const float c = 0.125f * 1.44269504089f; float sum = 0.f;
#pragma unroll
    for (int mt = 0; mt < 16; ++mt) {
#pragma unroll
        for (int j = 0; j < 4; ++j) { const float e = __builtin_amdgcn_exp2f((s[mt][j] - mx) * c); s[mt][j] = e; sum += e; } }
    sum = pg8::xsum32(pg8::xsum16(sum));
    const float inv = 1.0f / sum;
    f32x4 o[4];
#pragma unroll
    for (int dt = 0; dt < 4; ++dt) o[dt] = (f32x4){0.f, 0.f, 0.f, 0.f};
#pragma unroll
    for (int st = 0; st < 8; st += 2) { const bf16x8 pf0 = pack_frag(s[2 * st] * inv, s[2 * st + 1] * inv), pf1 = pack_frag(s[2 * st + 2] * inv, s[2 * st + 3] * inv);
        bf16x8 fa_[8];
#pragma unroll
        for (int k = 0; k < 8; ++k) { const int dt = k & 3, sx = st + (k >> 2); const LAS unsigned char* vp = VT + (16 * dt + r16) * 528 + (32 * sx + 4 * quad) * 2; fa_[k] = lds_frag_split(vp, vp + 32); }
        __builtin_amdgcn_sched_barrier(0);
#pragma unroll
        for (int k = 0; k < 8; ++k) o[k & 3] = mfma16(fa_[k], (k >> 2) ? pf1 : pf0, o[k & 3]);
        __builtin_amdgcn_sched_barrier(0); }
    bf16* opb = CAT + (size_t)t0 * DM + ocol; const unsigned opo = (unsigned)((16 * w + r16) * DM + 4 * quad) * 2u;
#pragma unroll
    for (int dt = 0; dt < 4; dt += 2) gst8x2(opb, opo + 32u * dt, pk4(o[dt][0], o[dt][1], o[dt][2], o[dt][3]), pk4(o[dt + 1][0], o[dt + 1][1], o[dt + 1][2], o[dt + 1][3]), quad);
}

__device__ __forceinline__ void mixer_a_unit(Frame& F, const Args& A, int unit) {
    unsigned char* ws = A.ws;
    const bf16* H0 = (const bf16*)(ws + WS_H0); bf16* CAT = (bf16*)(ws + WS_CAT0); const bf16* SG = (const bf16*)(ws + WS_SGWB);
    const float* lng = inp(F, 4); const float* lnb = inp(F, 5); const float* sgb = inp(F, 7);
    const int t0 = unit * 128, tid = F.tid, lane = F.lane, r16 = lane & 15, quad = lane >> 4, w = F.wave, b = t0 / SEQ;
    LAS float* STAT = (LAS float*)(F.lds + RING_OFF);
    LAS unsigned char* WS_ = F.lds + RING_OFF + 1024;
    LAS unsigned char* VT = WS_ + 128 * 272;
    LAS float* LNG = (LAS float*)(VT + 128 * 208); LAS float* LNB = LNG + MIXW;
    static_assert(1024 + 128 * 272 + 128 * 208 + 2 * MIXW * 4 <= RING_BYTES, "P2 LDS map");
    v4u gw_[4], gv_[3]; v2u gu_[6];
#define MIX_ISSUE(g) do { _Pragma("unroll") for (int i = 0; i < 4; ++i) { const int id = tid + 512 * i, p = id >> 4, ch = id & 15; gw_[i] = gld16(SG + (size_t)(g) * 16384, (unsigned)(p * 128 + ch * 8) * 2u); } \
        _Pragma("unroll") for (int i = 0; i < 3; ++i) { const int id = tid + 512 * i, q = id & 127, cc = id >> 7; gv_[i] = gld16(H0 + (size_t)t0 * NINA + MIXW + (g) * 96, (unsigned)(q * NINA + cc * 8) * 2u); } \
        _Pragma("unroll") for (int ct = 0; ct < 6; ++ct) gu_[ct] = gld8(H0 + (size_t)t0 * NINA + (g) * 96, (unsigned)((16 * w + r16) * NINA + 4 * quad + 16 * ct) * 2u); } while (0)
    { const bool two = tid + NWAVES * 64 < MIXW;
      const float g0_ = gld4(lng, (unsigned)tid * 4u), b0_ = gld4(lnb, (unsigned)tid * 4u), g1_ = two ? gld4(lng, (unsigned)(tid + NWAVES * 64) * 4u) : 0.f, b1_ = two ? gld4(lnb, (unsigned)(tid + NWAVES * 64) * 4u) : 0.f;
      LNG[tid] = g0_; LNB[tid] = b0_; if (two) { LNG[tid + NWAVES * 64] = g1_; LNB[tid + NWAVES * 64] = b1_; } }
    float bias_[8];
#pragma unroll
    for (int g = 0; g < 8; ++g) bias_[g] = gld4(sgb, (unsigned)(g * 128 + 16 * w + r16) * 4u);
    MIX_ISSUE(0);
    v2u rall[16][3];
#pragma unroll
    for (int k = 0; k < 16; ++k) { const bf16* vp = H0 + (size_t)(t0 + 16 * w + k) * NINA + MIXW;
#pragma unroll
        for (int j = 0; j < 3; ++j) rall[k][j] = gld8(vp, (unsigned)(4 * lane + 256 * j) * 2u); }
#pragma unroll
    for (int rr = 0; rr < 16; rr += 4) { v2u r[4][3];
#pragma unroll
        for (int k = 0; k < 4; ++k)
#pragma unroll
            for (int j = 0; j < 3; ++j) r[k][j] = rall[rr + k][j];
        float sm[4], q[4];
#pragma unroll
        for (int k = 0; k < 4; ++k) { sm[k] = 0.f;
#pragma unroll
            for (int j = 0; j < 3; ++j) sm[k] += (bflo(r[k][j].x) + bfhi(r[k][j].x)) + (bflo(r[k][j].y) + bfhi(r[k][j].y)); }
#pragma unroll
        for (int k = 0; k < 4; ++k) sm[k] = wave_sum(sm[k]);
#pragma unroll
        for (int k = 0; k < 4; ++k) { const float mean = sm[k] * (1.0f / 768.0f); sm[k] = mean; q[k] = 0.f;
#pragma unroll
            for (int j = 0; j < 3; ++j) { const float d0 = bflo(r[k][j].x) - mean, d1 = bfhi(r[k][j].x) - mean, d2 = bflo(r[k][j].y) - mean, d3 = bfhi(r[k][j].y) - mean; q[k] += (d0 * d0 + d1 * d1) + (d2 * d2 + d3 * d3); } }
#pragma unroll
        for (int k = 0; k < 4; ++k) q[k] = wave_sum(q[k]);
        if (lane == 0) {
#pragma unroll
            for (int k = 0; k < 4; ++k) { STAT[2 * (16 * w + rr + k)] = sm[k]; STAT[2 * (16 * w + rr + k) + 1] = 1.0f / sqrtf(q[k] * (1.0f / 768.0f) + LN_EPS); } } }
    LBAR();
    for (int g = 0; g < 8; ++g) {
#pragma unroll
        for (int i = 0; i < 4; ++i) { const int id = tid + 512 * i, p = id >> 4, ch = id & 15; *(LAS v4u*)(WS_ + p * 272 + ch * 16) = gw_[i]; }
#pragma unroll
        for (int i = 0; i < 3; ++i) { const int id = tid + 512 * i, q = id & 127, cc = id >> 7; const int c0 = g * 96 + cc * 8;
            const v4u r = gv_[i];
            const float mean = STAT[2 * q], rstd = STAT[2 * q + 1];
            const f32x4 g0 = *(const LAS f32x4*)(LNG + c0), g1 = *(const LAS f32x4*)(LNG + c0 + 4), b0 = *(const LAS f32x4*)(LNB + c0), b1 = *(const LAS f32x4*)(LNB + c0 + 4);
            v4u o_;
            o_.x = pk2((bflo(r.x) - mean) * rstd * g0.x + b0.x, (bfhi(r.x) - mean) * rstd * g0.y + b0.y); o_.y = pk2((bflo(r.y) - mean) * rstd * g0.z + b0.z, (bfhi(r.y) - mean) * rstd * g0.w + b0.w);
            o_.z = pk2((bflo(r.z) - mean) * rstd * g1.x + b1.x, (bfhi(r.z) - mean) * rstd * g1.y + b1.y); o_.w = pk2((bflo(r.w) - mean) * rstd * g1.z + b1.z, (bfhi(r.w) - mean) * rstd * g1.w + b1.w);
            *(LAS v4u*)(VT + q * 208 + cc * 16) = o_; }
        LBAR();
        v2u uu[6];
#pragma unroll
        for (int ct = 0; ct < 6; ++ct) uu[ct] = gu_[ct];
        if (g < 7) MIX_ISSUE(g + 1);
        const int p = 16 * w + r16; float bias = bias_[0];
#pragma unroll
        for (int k = 1; k < 8; ++k) bias = (g == k) ? bias_[k] : bias;
        bf16* opb = CAT + (size_t)t0 * DM + g * 96; const unsigned opo = (unsigned)(p * DM + 4 * quad) * 2u;
        f32x4 acc[6];
#pragma unroll
        for (int ct = 0; ct < 6; ++ct) acc[ct] = (f32x4){0.f, 0.f, 0.f, 0.f};
#pragma unroll
        for (int ks = 0; ks < 4; ++ks) { const bf16x8 wf = lds_frag(WS_ + (16 * w + r16) * 272 + ks * 64 + quad * 16); bf16x8 fa_[6];
#pragma unroll
            for (int ct = 0; ct < 6; ++ct) fa_[ct] = lds_frag_tr(VT + (32 * ks + 8 * quad) * 208 + 16 * ct * 2, 208, lane);
            __builtin_amdgcn_sched_barrier(0);
#pragma unroll
            for (int ct = 0; ct < 6; ++ct) acc[ct] = mfma16(fa_[ct], wf, acc[ct]);
            __builtin_amdgcn_sched_barrier(0); }
#pragma unroll
        for (int ct = 0; ct < 6; ct += 2) { const v2u u = uu[ct], u2 = uu[ct + 1];
            gst8x2(opb, opo + 32u * ct, pk4(bflo(u.x) * (acc[ct][0] + bias), bfhi(u.x) * (acc[ct][1] + bias), bflo(u.y) * (acc[ct][2] + bias), bfhi(u.y) * (acc[ct][3] + bias)),
                   pk4(bflo(u2.x) * (acc[ct + 1][0] + bias), bfhi(u2.x) * (acc[ct + 1][1] + bias), bflo(u2.y) * (acc[ct + 1][2] + bias), bfhi(u2.y) * (acc[ct + 1][3] + bias)), quad); }
        LBAR();
    }
#undef MIX_ISSUE
    AttnRegs AR; attn_issue(AR, tid, H0 + 2 * MIXW, NINA, b, 0, t0, (const bf16*)(ws + WS_MEMK), (const bf16*)(ws + WS_MEMVT));
    for (int hh = 0; hh < 4; ++hh) {
        attn_commit(F, AR); LBAR();
        if (hh < 3) attn_issue(AR, tid, H0 + 2 * MIXW + (hh + 1) * 64, NINA, b, hh + 1, t0, (const bf16*)(ws + WS_MEMK), (const bf16*)(ws + WS_MEMVT));
        attn_compute(F, t0, CAT, MIXW + hh * 64); LBAR(); }
}

__device__ __forceinline__ void ln_rows(Frame& F, const float* Z, const float* g, const float* b, bf16* X) {
    const int gw = F.vcu * NWAVES + F.wave, NGW = F.G * NWAVES;
    f32x4 gv[4], bv[4];
#pragma unroll
    for (int j = 0; j < 4; ++j) { gv[j] = ((const GAS f32x4*)g)[F.lane + 64 * j]; bv[j] = ((const GAS f32x4*)b)[F.lane + 64 * j]; }
    for (int m = gw; m < NTOK; m += NGW) { const GAS f32x4* zr = (const GAS f32x4*)(Z + (size_t)m * DM) + F.lane;
        f32x4 v[4]; float s = 0.f;
#pragma unroll
        for (int j = 0; j < 4; ++j) { v[j] = zr[64 * j]; s += (v[j].x + v[j].y) + (v[j].z + v[j].w); }
        const float mean = wave_sum(s) * (1.f / DM); float s2 = 0.f;
#pragma unroll
        for (int j = 0; j < 4; ++j) { v[j] = v[j] - mean; s2 += (v[j].x * v[j].x + v[j].y * v[j].y) + (v[j].z * v[j].z + v[j].w * v[j].w); }
        const float rstd = 1.f / sqrtf(wave_sum(s2) * (1.f / DM) + LN_EPS);
        GAS unsigned long long* o8 = (GAS unsigned long long*)(X + (size_t)m * DM) + F.lane;
#pragma unroll
        for (int j = 0; j < 4; ++j) { const f32x4 y = v[j] * rstd * gv[j] + bv[j]; o8[64 * j] = pk4(y.x, y.y, y.z, y.w); } }
}

struct KvRegs { v4u k[4], v[6]; };
__device__ __forceinline__ void kv_issue(KvRegs& R, int tid, const bf16* H1, int unit) {
    const int h = unit & 3, t0 = (unit >> 2) * 128;
#pragma unroll
    for (int i = 0; i < 2; ++i) { const int id = tid + 512 * i; if (id < 768) { const int j = id & 127, gq = id >> 7;
        const unsigned ko = (unsigned)(j * NINB + gq * 8) * 2u; const bf16* kbase = H1 + (size_t)t0 * NINB + QKW + h * 96; R.k[2 * i] = gld16(kbase, ko); R.k[2 * i + 1] = gld16(kbase, ko + 96u); } }
#pragma unroll
    for (int i = 0; i < 6; ++i) { const int id = tid + 512 * i, j = id & 127, ec = id >> 7; R.v[i] = gld16(H1 + (size_t)t0 * NINB + 2 * QKW + h * 192, (unsigned)(j * NINB + ec * 8) * 2u); }
}
__device__ __forceinline__ void ret_kv_phase(Frame& F, const Args& A) {
    unsigned char* ws = A.ws;
    const bf16* H1 = (const bf16*)(ws + WS_H1); bf16* KVS = (bf16*)A.out; const float* prm = (const float*)(ws + WS_PRM);
    const int w = F.wave;
    LAS unsigned char* KF = F.lds + RING_OFF; LAS unsigned char* KB = KF + 96 * 272; LAS unsigned char* VT = KB + 96 * 272;
    int unit = F.vcu; if (unit >= 1024) return;
    KvRegs R; kv_issue(R, F.tid, H1, unit);
    for (; unit < 1024; unit += F.G) {
        const int h = unit & 3; const float l2f = prm[h], l2b = prm[4 + h];
        int tid = F.tid; asm volatile("" : "+v"(tid));
#pragma unroll
        for (int i = 0; i < 2; ++i) { const int id = tid + 512 * i; if (id < 768) { const int j = id & 127, gq = id >> 7; const v4u r1 = R.k[2 * i], r2 = R.k[2 * i + 1];
            const float sf = __builtin_amdgcn_exp2f((float)(128 - j) * l2f), sb = __builtin_amdgcn_exp2f((float)(j + 1) * l2b);
            const float t1[8] = {bflo(r1.x), bfhi(r1.x), bflo(r1.y), bfhi(r1.y), bflo(r1.z), bfhi(r1.z), bflo(r1.w), bfhi(r1.w)};
            const float t2[8] = {bflo(r2.x), bfhi(r2.x), bflo(r2.y), bfhi(r2.y), bflo(r2.z), bfhi(r2.z), bflo(r2.w), bfhi(r2.w)};
            LAS unsigned short* kf = (LAS unsigned short*)(KF + (gq * 8) * 272 + j * 2); LAS unsigned short* kb = (LAS unsigned short*)(KB + (gq * 8) * 272 + j * 2);
#pragma unroll
            for (int e = 0; e < 8; ++e) { const float o1 = t1[e], o2 = t2[e];
                kf[e * 136] = (unsigned short)f2bf(o1 * sf); kf[(48 + e) * 136] = (unsigned short)f2bf(o2 * sf);
                kb[e * 136] = (unsigned short)f2bf(o1 * sb); kb[(48 + e) * 136] = (unsigned short)f2bf(o2 * sb); } } }
#pragma unroll
        for (int i = 0; i < 6; ++i) { const int id = tid + 512 * i, j = id & 127, ec = id >> 7;
            *(LAS v4u*)(VT + j * 400 + ec * 16) = R.v[i]; }
        LBAR();
        asm volatile("" : "+v"(tid));
        if (unit + F.G < 1024) kv_issue(R, tid, H1, unit + F.G);
        const int lane = tid & 63, r16 = lane & 15, quad = lane >> 4;
        const int dir = w & 1, eg = w >> 1; const LAS unsigned char* KX = dir ? KB : KF;
        f32x4 acc[3][6];
#pragma unroll
        for (int et = 0; et < 3; ++et)
#pragma unroll
            for (int dt = 0; dt < 6; ++dt) acc[et][dt] = (f32x4){0.f, 0.f, 0.f, 0.f};
#pragma unroll
        for (int ks = 0; ks < 4; ++ks) { bf16x8 kf[6];
#pragma unroll
            for (int dt = 0; dt < 6; ++dt) kf[dt] = lds_frag(KX + (16 * dt + r16) * 272 + ks * 64 + quad * 16);
#pragma unroll
            for (int et = 0; et < 3; ++et) { const bf16x8 vf = lds_frag_tr(VT + (32 * ks + 8 * quad) * 400 + 16 * (3 * eg + et) * 2, 400, lane);
#pragma unroll
                for (int dt = 0; dt < 6; ++dt) acc[et][dt] = mfma16(kf[dt], vf, acc[et][dt]); } }
        bf16* out = KVS + ((size_t)unit * 2 + dir) * (192 * 96);
#pragma unroll
        for (int et = 0; et < 3; ++et) { const int e = 16 * (3 * eg + et) + r16;
#pragma unroll
            for (int dt = 0; dt < 6; dt += 2) gst8x2(out, (unsigned)(e * 96 + 16 * dt + 4 * quad) * 2u, pk4(acc[et][dt][0], acc[et][dt][1], acc[et][dt][2], acc[et][dt][3]), pk4(acc[et][dt + 1][0], acc[et][dt + 1][1], acc[et][dt + 1][2], acc[et][dt + 1][3]), quad); }
        LBAR();
    }
}

__device__ __forceinline__ void ret_scan(Frame& F, const Args& A) {
    bf16* KVS = (bf16*)A.out; const float* prm = (const float*)(A.ws + WS_PRM);
    const int gt = F.vcu * (NWAVES * 64) + F.tid, NGT = F.G * NWAVES * 64;
    for (int idx = gt; idx < 32 * 2304; idx += NGT) { const int combo = idx / 2304, v = idx - combo * 2304, b = combo >> 3, h = (combo >> 1) & 3, dir = combo & 1;
        const float decay = __builtin_amdgcn_exp2f(128.0f * prm[dir * 4 + h]);
        float S[8];
#pragma unroll
        for (int j = 0; j < 8; ++j) S[j] = 0.f;
#define SCAN_PTR(st) ((GAS v4u*)(KVS + ((size_t)(((b * 64 + (dir ? 63 - (st) : (st))) * 4 + h) * 2 + dir)) * (192 * 96) + (size_t)v * 8))
#define SCAN_LOAD(r, st0) do { _Pragma("unroll") for (int u = 0; u < 4; ++u) r[u] = __builtin_nontemporal_load(SCAN_PTR((st0) + u)); } while (0)
#define SCAN_STEP(r, st0) do { _Pragma("unroll") for (int u = 0; u < 4; ++u) { const float t[8] = {bflo(r[u].x), bfhi(r[u].x), bflo(r[u].y), bfhi(r[u].y), bflo(r[u].z), bfhi(r[u].z), bflo(r[u].w), bfhi(r[u].w)}; \
            v4u o; o.x = pk2(S[0], S[1]); o.y = pk2(S[2], S[3]); o.z = pk2(S[4], S[5]); o.w = pk2(S[6], S[7]); *SCAN_PTR((st0) + u) = o; \
            _Pragma("unroll") for (int j = 0; j < 8; ++j) S[j] = S[j] * decay + t[j]; } } while (0)
        v4u ra[4], rb[4]; SCAN_LOAD(ra, 0);
        for (int step = 0; step < 64; step += 8) {
            SCAN_LOAD(rb, step + 4);
            SCAN_STEP(ra, step);
            if (step + 8 < 64) SCAN_LOAD(ra, step + 8);
            SCAN_STEP(rb, step + 4); }
#undef SCAN_PTR
#undef SCAN_LOAD
#undef SCAN_STEP
    }
}

struct RetRegs { v4u qk[6]; };
__device__ __forceinline__ void ret_issue(RetRegs& R, int tid, const bf16* H1, int unit) {
    const int h = unit & 3, t0 = (unit >> 2) * 128;
#pragma unroll
    for (int i = 0; i < 3; ++i) { const int id = tid + 512 * i, isk = id >= 768, id2 = isk ? id - 768 : id, row = id2 / 6, gq = id2 - row * 6;
        const unsigned qo = (unsigned)(row * NINB + (isk ? QKW : 0) + gq * 8) * 2u; const bf16* qbase = H1 + (size_t)t0 * NINB + h * 96; R.qk[2 * i] = gld16(qbase, qo); R.qk[2 * i + 1] = gld16(qbase, qo + 96u); }
}
__device__ __forceinline__ void ret_out_phase(Frame& F, const Args& A) {
    unsigned char* ws = A.ws;
    const bf16* H1 = (const bf16*)(ws + WS_H1); const bf16* KVS = (const bf16*)A.out; bf16* CAT = (bf16*)(ws + WS_CAT1);
    const float* prm = (const float*)(ws + WS_PRM); const float* gng = inp(F, 11); const float* gnb = inp(F, 12);
    const int w = F.wave;
    LAS unsigned char* QS = F.lds + RING_OFF; LAS unsigned char* VT = QS + 128 * 208; LAS unsigned char* XS = VT + 192 * 272;
    LAS float* GNG = (LAS float*)(XS + 192 * 208); LAS float* GNB = GNG + MIXW;
    static_assert(128 * 208 + 192 * 272 + 192 * 208 + 2 * MIXW * 4 <= RING_BYTES, "P11 LDS map");
    for (int i = F.tid; i < MIXW; i += NWAVES * 64) { GNG[i] = gld4(gng, (unsigned)i * 4u); GNB[i] = gld4(gnb, (unsigned)i * 4u); }
    int unit = F.vcu; if (unit >= 1024) return;
    RetRegs RR; ret_issue(RR, F.tid, H1, unit);
#define REPIN(v) do { v = F.tid; asm volatile("" : "+v"(v)); } while (0)
    for (; unit < 1024; unit += F.G) {
        const int h = unit & 3, bn = unit >> 2, t0 = bn * 128; const float l2f = prm[h], l2b = prm[4 + h];
        int tid; REPIN(tid); int lane = tid & 63, r16 = lane & 15, quad = lane >> 4;
#pragma unroll
        for (int i = 0; i < 3; ++i) { const int id = tid + 512 * i, isk = id >= 768, id2 = isk ? id - 768 : id, row = id2 / 6, gq = id2 - row * 6;
            LAS unsigned char* dst = (isk ? XS : QS) + row * 208 + gq * 16; *(LAS v4u*)dst = RR.qk[2 * i]; *(LAS v4u*)(dst + 96) = RR.qk[2 * i + 1]; }
        v4u vv[6];
#pragma unroll
        for (int i = 0; i < 6; ++i) { const int id = tid + 512 * i, j = id & 127, ec = id >> 7; vv[i] = gld16(H1 + (size_t)t0 * NINB + 2 * QKW + h * 192, (unsigned)(j * NINB + ec * 8) * 2u); }
        const bf16* SF = KVS + ((size_t)unit * 2 + 0) * (192 * 96); const bf16* SB = KVS + ((size_t)unit * 2 + 1) * (192 * 96);
        REPIN(tid);
        v4u st[5];
#pragma unroll
        for (int i = 0; i < 5; ++i) { const int id = tid + 512 * i; if (id < 2304) st[i] = gld16(SF, (unsigned)id * 16u); }
        LBAR();
        const int ii = 16 * w + r16;
        bf16x8 qf[3], pf[4];
        { f32x4 sc_[8];
#pragma unroll
          for (int jt = 0; jt < 8; ++jt) sc_[jt] = (f32x4){0.f, 0.f, 0.f, 0.f};
#pragma unroll
          for (int ks = 0; ks < 3; ++ks) { qf[ks] = lds_frag(QS + ii * 208 + ks * 64 + quad * 16);
#pragma unroll
              for (int jt = 0; jt < 8; ++jt) sc_[jt] = mfma16(lds_frag(XS + (16 * jt + r16) * 208 + ks * 64 + quad * 16), qf[ks], sc_[jt]); }
          int iv = ii - 4 * quad; asm volatile("" : "+v"(iv));
#pragma unroll
          for (int jt = 0; jt < 8; ++jt)
#pragma unroll
              for (int r = 0; r < 4; ++r) { const int df = iv - (16 * jt + r); const float m = df >= 0 ? __builtin_amdgcn_exp2f((float)df * l2f) : __builtin_amdgcn_exp2f((float)(-df) * l2b); sc_[jt][r] *= m; }
#pragma unroll
          for (int st4 = 0; st4 < 4; ++st4) pf[st4] = pack_frag(sc_[2 * st4], sc_[2 * st4 + 1]); }
        REPIN(tid);
#pragma unroll
        for (int i = 0; i < 6; ++i) { const int id = tid + 512 * i, j = id & 127, ec = id >> 7; *(LAS v4u*)(VT + j * 400 + ec * 16) = vv[i]; }
        LBAR();
        REPIN(tid); lane = tid & 63; r16 = lane & 15; quad = lane >> 4;
#pragma unroll
        for (int i = 0; i < 5; ++i) { const int id = tid + 512 * i; if (id < 2304) { const int e = id / 12, ch = id - e * 12; *(LAS v4u*)(XS + e * 208 + ch * 16) = st[i]; } }
#pragma unroll
        for (int i = 0; i < 5; ++i) { const int id = tid + 512 * i; if (id < 2304) st[i] = gld16(SB, (unsigned)id * 16u); }
        v2u gr[12];
#pragma unroll
        for (int et = 0; et < 12; ++et) gr[et] = gld8(H1 + (size_t)t0 * NINB + 2 * QKW + MIXW + h * 192, (unsigned)(ii * NINB + 4 * quad + 16 * et) * 2u);
        f32x4 o[12];
#pragma unroll
        for (int et = 0; et < 12; ++et) o[et] = (f32x4){0.f, 0.f, 0.f, 0.f};
#pragma unroll
        for (int st4 = 0; st4 < 4; ++st4)
        { bf16x8 fa_[12];
#pragma unroll
            for (int et = 0; et < 12; ++et) fa_[et] = lds_frag_tr(VT + (32 * st4 + 4 * quad) * 400 + 16 * et * 2, 400, lane, 16);
            __builtin_amdgcn_sched_barrier(0);
#pragma unroll
            for (int et = 0; et < 12; ++et) o[et] = mfma16(fa_[et], pf[st4], o[et]);
            __builtin_amdgcn_sched_barrier(0); }
        LBAR();
        { const float sc = __builtin_amdgcn_exp2f((float)ii * l2f);
#pragma unroll
          for (int ks = 0; ks < 3; ++ks) { const bf16x8 q2 = scale_frag(qf[ks], sc);
#pragma unroll
              for (int eh = 0; eh < 12; eh += 6) { bf16x8 fa_[6];
#pragma unroll
                  for (int et = 0; et < 6; ++et) fa_[et] = lds_frag(XS + (16 * (eh + et) + r16) * 208 + ks * 64 + quad * 16);
                  __builtin_amdgcn_sched_barrier(0);
#pragma unroll
                  for (int et = 0; et < 6; ++et) o[eh + et] = mfma16(fa_[et], q2, o[eh + et]);
                  __builtin_amdgcn_sched_barrier(0); } } }
        LBAR();
        REPIN(tid); lane = tid & 63; r16 = lane & 15; quad = lane >> 4;
#pragma unroll
        for (int i = 0; i < 5; ++i) { const int id = tid + 512 * i; if (id < 2304) { const int e = id / 12, ch = id - e * 12; *(LAS v4u*)(XS + e * 208 + ch * 16) = st[i]; } }
        AttnRegs AR; attn_issue(AR, tid, H1 + 2 * QKW + 2 * MIXW + h * 64, NINB, t0 / SEQ, h, t0, (const bf16*)(ws + WS_MEMK), (const bf16*)(ws + WS_MEMVT));
        LBAR();
        { const float sc = __builtin_amdgcn_exp2f((float)(127 - ii) * l2b);
#pragma unroll
          for (int ks = 0; ks < 3; ++ks) { const bf16x8 q2 = scale_frag(qf[ks], sc);
#pragma unroll
              for (int eh = 0; eh < 12; eh += 6) { bf16x8 fa_[6];
#pragma unroll
                  for (int et = 0; et < 6; ++et) fa_[et] = lds_frag(XS + (16 * (eh + et) + r16) * 208 + ks * 64 + quad * 16);
                  __builtin_amdgcn_sched_barrier(0);
#pragma unroll
                  for (int et = 0; et < 6; ++et) o[eh + et] = mfma16(fa_[et], q2, o[eh + et]);
                  __builtin_amdgcn_sched_barrier(0); } } }
        float sm = 0.f;
#pragma unroll
        for (int et = 0; et < 12; ++et) sm += (o[et][0] + o[et][1]) + (o[et][2] + o[et][3]);
        sm = pg8::xsum32(pg8::xsum16(sm));
        const float mean = sm * (1.0f / 192.0f); float q = 0.f;
#pragma unroll
        for (int et = 0; et < 12; ++et) { o[et] = o[et] - mean; q += (o[et][0] * o[et][0] + o[et][1] * o[et][1]) + (o[et][2] * o[et][2] + o[et][3] * o[et][3]); }
        q = pg8::xsum32(pg8::xsum16(q));
        const float rstd = 1.0f / sqrtf(q * (1.0f / 192.0f) + LN_EPS);
        bf16* opb = CAT + (size_t)t0 * DM + h * 192; const unsigned opo = (unsigned)(ii * DM + 4 * quad) * 2u;
#pragma unroll
        for (int et = 0; et < 12; et += 2) { unsigned long long pv[2];
#pragma unroll
            for (int k = 0; k < 2; ++k) { const int e2 = et + k; const f32x4 gg = *(const LAS f32x4*)(GNG + h * 192 + 4 * quad + 16 * e2), gb = *(const LAS f32x4*)(GNB + h * 192 + 4 * quad + 16 * e2);
                const f32x4 y = o[e2] * rstd * gg + gb;
                pv[k] = pk4(silu_f(bflo(gr[e2].x)) * y[0], silu_f(bfhi(gr[e2].x)) * y[1], silu_f(bflo(gr[e2].y)) * y[2], silu_f(bfhi(gr[e2].y)) * y[3]); }
            gst8x2(opb, opo + 32u * et, pv[0], pv[1], quad); }
        LBAR();
        attn_commit(F, AR);
        REPIN(tid);
        if (unit + F.G < 1024) ret_issue(RR, tid, H1, unit + F.G);
        LBAR();
        attn_compute(F, t0, CAT, MIXW + h * 64);
        LBAR();
    }
#undef REPIN
}

__device__ __forceinline__ void ln_router(Frame& F, const Args& A, const bf16* Zb, const float* g, const float* b, unsigned char* XQ) {
    const int gw = F.vcu * NWAVES + F.wave, NGW = F.G * NWAVES;
    const float* wr = inp(F, 19); const float* br = inp(F, 20);
    LAS float* WT = (LAS float*)(F.lds + RING_OFF);
    for (int i = F.tid; i < 8192; i += NWAVES * 64) WT[(i & 7) * 1024 + (i >> 3)] = wr[i];
    __syncthreads();
    int* topi = (int*)(A.ws + WS_TOPI); float* gate = (float*)(A.ws + WS_GATE); unsigned* hist = (unsigned*)(F.ctl + CW_HIST);
    f32x4 gv[4], bv[4];
#pragma unroll
    for (int j = 0; j < 4; ++j) { gv[j] = ((const GAS f32x4*)g)[F.lane + 64 * j]; bv[j] = ((const GAS f32x4*)b)[F.lane + 64 * j]; }
    float brv[8];
#pragma unroll
    for (int e = 0; e < 8; ++e) brv[e] = br[e];
    constexpr int PD = 4;
    v2u rawq[PD][4];
#pragma unroll
    for (int d = 0; d < PD; ++d) if (gw + d * NGW < NTOK) {
#pragma unroll
        for (int j = 0; j < 4; ++j) rawq[d][j] = __builtin_nontemporal_load((const GAS v2u*)(Zb + (size_t)(gw + d * NGW) * DM) + F.lane + 64 * j); }
    for (int mb = gw; mb < NTOK; mb += PD * NGW) {
#pragma unroll
      for (int d = 0; d < PD; ++d) { const int m = mb + d * NGW; if (m >= NTOK) break; v2u (&raw)[4] = rawq[d];
        f32x4 v[4]; float s = 0.f;
#pragma unroll
        for (int j = 0; j < 4; ++j) { const v2u q = raw[j]; v[j] = (f32x4){bflo(q.x), bfhi(q.x), bflo(q.y), bfhi(q.y)}; s += (v[j].x + v[j].y) + (v[j].z + v[j].w); }
        if (m + PD * NGW < NTOK) {
#pragma unroll
            for (int j = 0; j < 4; ++j) raw[j] = __builtin_nontemporal_load((const GAS v2u*)(Zb + (size_t)(m + PD * NGW) * DM) + F.lane + 64 * j); }
        const float mean = wave_sum(s) * (1.f / DM); float s2 = 0.f;
#pragma unroll
        for (int j = 0; j < 4; ++j) { v[j] = v[j] - mean; s2 += (v[j].x * v[j].x + v[j].y * v[j].y) + (v[j].z * v[j].z + v[j].w * v[j].w); }
        const float rstd = 1.f / sqrtf(wave_sum(s2) * (1.f / DM) + LN_EPS);
#pragma unroll
        for (int j = 0; j < 4; ++j) { v[j] = v[j] * rstd * gv[j] + bv[j];
            ((GAS unsigned*)(XQ + (size_t)m * DM))[F.lane + 64 * j] = pk_i8x4(v[j].x * ZQ_SCALE, v[j].y * ZQ_SCALE, v[j].z * ZQ_SCALE, v[j].w * ZQ_SCALE); }
        float pe_[8];
#pragma unroll
        for (int e = 0; e < 8; ++e) { float p = 0.f;
#pragma unroll
            for (int j = 0; j < 4; ++j) { const f32x4 wv = *(const LAS f32x4*)(WT + e * 1024 + 4 * F.lane + 256 * j); p += (v[j].x * wv.x + v[j].y * wv.y) + (v[j].z * wv.z + v[j].w * wv.w); }
            pe_[e] = p; }
        const bool h3 = (F.lane & 8) != 0;
        float q4[4], q2[2], q1;
#pragma unroll
        for (int k = 0; k < 4; ++k) { const auto r = __builtin_amdgcn_permlane32_swap(__float_as_uint(pe_[k]), __float_as_uint(pe_[k + 4]), false, false); q4[k] = __uint_as_float(r[0]) + __uint_as_float(r[1]); }
#pragma unroll
        for (int k = 0; k < 2; ++k) { const auto r = __builtin_amdgcn_permlane16_swap(__float_as_uint(q4[k]), __float_as_uint(q4[k + 2]), false, false); q2[k] = __uint_as_float(r[0]) + __uint_as_float(r[1]); }
        { const float snd = h3 ? q2[0] : q2[1], kp = h3 ? q2[1] : q2[0]; q1 = kp + pg8::dpp_f<pg8::DPP_RM>(snd); }
        q1 = pg8::sum8(q1);
        float lg[8];
#pragma unroll
        for (int e = 0; e < 8; ++e) lg[e] = __uint_as_float((unsigned)__builtin_amdgcn_readlane((int)__float_as_uint(q1), 8 * e)) + brv[e];
        int e0 = 0; float l0 = lg[0];
#pragma unroll
        for (int e = 1; e < 8; ++e) if (lg[e] > l0) { l0 = lg[e]; e0 = e; }
        int e1 = -1; float l1 = -3.0e38f;
#pragma unroll
        for (int e = 0; e < 8; ++e) if (e != e0 && lg[e] > l1) { l1 = lg[e]; e1 = e; }
        if (F.lane == 0) { const float w0 = 1.0f / (1.0f + __builtin_amdgcn_exp2f((l1 - l0) * 1.44269504089f));
            topi[2 * m] = e0; topi[2 * m + 1] = e1; gate[2 * m] = w0; gate[2 * m + 1] = 1.0f - w0;
            atomicAdd(hist + (m >> 7) * 8 + e0, 1u); atomicAdd(hist + (m >> 7) * 8 + e1, 1u); } } }
    __syncthreads();
}

__device__ __forceinline__ void route_positions(Frame& F, const Args& A) {
    LAS int* bh = (LAS int*)(F.lds + RING_OFF); LAS int* pre = bh + 2048; LAS int* cnt = pre + 2048;
    const unsigned* hist = (const unsigned*)(F.ctl + CW_HIST);
    for (int i = F.tid; i < 2048; i += NWAVES * 64) bh[i] = (int)hist[i];
    __syncthreads();
    if (F.tid < 8) { int run = 0; for (int blk = 0; blk < 256; ++blk) { pre[blk * 8 + F.tid] = run; run += bh[blk * 8 + F.tid]; } cnt[F.tid] = run; }
    __syncthreads();
    if (F.tid == 0) { int ps = 0; for (int e = 0; e < 8; ++e) { cnt[8 + e] = ps; ps += ((cnt[e] + 255) >> 8) << 8; } cnt[16] = ps >> 8; }
    __syncthreads();
    if (F.vcu == 0) { int* pe = (int*)(F.ctl + CW_PE);
        for (int p = F.tid; p < 272; p += NWAVES * 64) { const int row = p * 256; int e = 0;
#pragma unroll
            for (int ee = 1; ee < 8; ++ee) if (row >= cnt[8 + ee]) e = ee;
            pe[p] = e; }
        if (F.tid == 0) *(int*)(F.ctl + CW_NP) = cnt[16]; }
    const int* topi = (const int*)(A.ws + WS_TOPI); int* dest = (int*)(A.ws + WS_DEST); int* rowtok = (int*)(A.ws + WS_ROWTOK);
    if (F.wave == 0) for (int blk = F.vcu; blk < 256; blk += F.G) { int run[8];
#pragma unroll
        for (int e = 0; e < 8; ++e) run[e] = 0;
        const unsigned long long lt = (1ull << F.lane) - 1ull;
        for (int ps = 0; ps < 4; ++ps) { const int a = blk * 256 + ps * 64 + F.lane; const int e = topi[a]; int rank = 0;
#pragma unroll
            for (int ee = 0; ee < 8; ++ee) { const unsigned long long mk = __ballot(e == ee); if (e == ee) rank = run[ee] + __popcll(mk & lt); run[ee] += __popcll(mk); }
            const int d = cnt[8 + e] + pre[blk * 8 + e] + rank; dest[a] = d; rowtok[d] = a >> 1; } }
    __syncthreads();
}

__device__ __forceinline__ void final_rows(Frame& F, const Args& A) {
    const int gw = F.vcu * NWAVES + F.wave, NGW = F.G * NWAVES;
    const bf16* Z3b = (const bf16*)(A.ws + WS_X3); const bf16* YR = (const bf16*)(A.ws + WS_YR); const int* dest = (const int*)(A.ws + WS_DEST); const float* gate = (const float*)(A.ws + WS_GATE);
    const float* g3 = inp(F, 14) + 2 * DM; const float* b3 = inp(F, 15) + 2 * DM; const float* g = inp(F, 14) + 3 * DM; const float* b = inp(F, 15) + 3 * DM; float* out = A.out;
    f32x4 gv[4], bv[4], g3v[4], b3v[4];
#pragma unroll
    for (int j = 0; j < 4; ++j) { gv[j] = ((const GAS f32x4*)g)[F.lane + 64 * j]; bv[j] = ((const GAS f32x4*)b)[F.lane + 64 * j]; g3v[j] = ((const GAS f32x4*)g3)[F.lane + 64 * j] * ALPHA; b3v[j] = ((const GAS f32x4*)b3)[F.lane + 64 * j] * ALPHA; }
    int dA0 = 0, dA1 = 0, dB0 = 0, dB1 = 0; float wA0 = 0.f, wA1 = 0.f, wB0 = 0.f, wB1 = 0.f; v2u an[4], pn[4], qn[4];
    if (gw < NTOK) { dA0 = dest[2 * gw]; dA1 = dest[2 * gw + 1]; wA0 = gate[2 * gw]; wA1 = gate[2 * gw + 1];
#pragma unroll
        for (int j = 0; j < 4; ++j) { an[j] = __builtin_nontemporal_load((const GAS v2u*)(Z3b + (size_t)gw * DM) + F.lane + 64 * j); pn[j] = __builtin_nontemporal_load((const GAS v2u*)(YR + (size_t)dA0 * DM) + F.lane + 64 * j); qn[j] = __builtin_nontemporal_load((const GAS v2u*)(YR + (size_t)dA1 * DM) + F.lane + 64 * j); } }
    if (gw + NGW < NTOK) { dB0 = dest[2 * (gw + NGW)]; dB1 = dest[2 * (gw + NGW) + 1]; wB0 = gate[2 * (gw + NGW)]; wB1 = gate[2 * (gw + NGW) + 1]; }
    const float* PARTY = (const float*)(A.ws + WS_PARTY); constexpr int TAIL0 = 2 * PASS_PANELS * 256;
    for (int m = gw; m < NTOK; m += NGW) { const float w0 = wA0, w1 = wA1; const int dc0 = dA0, dc1 = dA1;
        f32x4 v[4]; v2u p[4], q[4]; float s = 0.f;
#pragma unroll
        for (int j = 0; j < 4; ++j) { const v2u a = an[j]; p[j] = pn[j]; q[j] = qn[j]; v[j] = (f32x4){bflo(a.x), bfhi(a.x), bflo(a.y), bfhi(a.y)}; s += (v[j].x + v[j].y) + (v[j].z + v[j].w); }
        if (m + NGW < NTOK) {
#pragma unroll
            for (int j = 0; j < 4; ++j) { an[j] = __builtin_nontemporal_load((const GAS v2u*)(Z3b + (size_t)(m + NGW) * DM) + F.lane + 64 * j); pn[j] = __builtin_nontemporal_load((const GAS v2u*)(YR + (size_t)dB0 * DM) + F.lane + 64 * j); qn[j] = __builtin_nontemporal_load((const GAS v2u*)(YR + (size_t)dB1 * DM) + F.lane + 64 * j); } }
        wA0 = wB0; wA1 = wB1; dA0 = dB0; dA1 = dB1;
        if (m + 2 * NGW < NTOK) { dB0 = dest[2 * (m + 2 * NGW)]; dB1 = dest[2 * (m + 2 * NGW) + 1]; wB0 = gate[2 * (m + 2 * NGW)]; wB1 = gate[2 * (m + 2 * NGW) + 1]; }
        float mean = wave_sum(s) * (1.f / DM); float s2 = 0.f;
#pragma unroll
        for (int j = 0; j < 4; ++j) { v[j] = v[j] - mean; s2 += (v[j].x * v[j].x + v[j].y * v[j].y) + (v[j].z * v[j].z + v[j].w * v[j].w); }
        float rstd = 1.f / sqrtf(wave_sum(s2) * (1.f / DM) + LN_EPS); s = 0.f;
#pragma unroll
        for (int j = 0; j < 4; ++j) { f32x4 f0 = (f32x4){bflo(p[j].x), bfhi(p[j].x), bflo(p[j].y), bfhi(p[j].y)}, f1 = (f32x4){bflo(q[j].x), bfhi(q[j].x), bflo(q[j].y), bfhi(q[j].y)};
            if (dc0 >= TAIL0) { f32x4 t[7];
#pragma unroll
                for (int ks = 0; ks < 7; ++ks) t[ks] = ((const GAS f32x4*)(PARTY + ((size_t)ks * 2048 + (dc0 - TAIL0)) * DM))[F.lane + 64 * j];
                f0 = ((t[0] + t[1]) + (t[2] + t[3])) + ((t[4] + t[5]) + t[6]); }
            if (dc1 >= TAIL0) { f32x4 t[7];
#pragma unroll
                for (int ks = 0; ks < 7; ++ks) t[ks] = ((const GAS f32x4*)(PARTY + ((size_t)ks * 2048 + (dc1 - TAIL0)) * DM))[F.lane + 64 * j];
                f1 = ((t[0] + t[1]) + (t[2] + t[3])) + ((t[4] + t[5]) + t[6]); }
            v[j] = v[j] * rstd * g3v[j] + b3v[j] + (f0 * w0 + f1 * w1); s += (v[j].x + v[j].y) + (v[j].z + v[j].w); }
        mean = wave_sum(s) * (1.f / DM); s2 = 0.f;
#pragma unroll
        for (int j = 0; j < 4; ++j) { v[j] = v[j] - mean; s2 += (v[j].x * v[j].x + v[j].y * v[j].y) + (v[j].z * v[j].z + v[j].w * v[j].w); }
        rstd = 1.f / sqrtf(wave_sum(s2) * (1.f / DM) + LN_EPS);
        GAS f32x4* o = (GAS f32x4*)(out + (size_t)m * DM) + F.lane;
#pragma unroll
        for (int j = 0; j < 4; ++j) __builtin_nontemporal_store(v[j] * rstd * gv[j] + bv[j], o + 64 * j); }
}

constexpr int N_PHASES = 17;
__global__ void __launch_bounds__(NWAVES * 64, 2) hyb_fwd(Args args) {
    extern __shared__ __attribute__((aligned(16))) unsigned char lds[];
    Frame F;
    F.lds = (LAS unsigned char*)lds;
    F.MISC = (volatile LAS unsigned*)(F.lds + MISC_OFF);
    F.tid = threadIdx.x; F.lane = F.tid & 63; F.wave = __builtin_amdgcn_readfirstlane(F.tid >> 6);
    F.G = gridDim.x; { const int bx = blockIdx.x; F.vcu = (F.G % 8 == 0) ? (bx % 8) * (F.G / 8) + bx / 8 : bx; }
    unsigned char* ws = args.ws;
    F.ctl = (gu32*)(ws + WS_CTL);
    for (int u = F.tid; u < (LDS_BYTES - LDSCTL_OFF) / 4; u += NWAVES * 64) ((LAS unsigned*)(F.lds + LDSCTL_OFF))[u] = 0u;
    __syncthreads();
    if (F.tid == 0) { LAS unsigned long long* pt = (LAS unsigned long long*)(F.lds + PTR_OFF);
#pragma unroll
        for (int i = 0; i < 24; ++i) pt[i] = (unsigned long long)args.in[i]; }
    __syncthreads();
    XcdBarrier bar; bar.bar = (unsigned*)(F.ctl + CW_BAR); bar.x = 0; bar.st = nullptr;
    if (MK_SINGLE) bar = xcd_barrier_post((unsigned*)(F.ctl + CW_BAR), F.MISC + 8);
#define GRID_BAR() do { if (MK_SINGLE) xcd_barrier(bar); } while (0)
    const int lo = args.ph_lo, hi = args.ph_hi;
#define IN(k) (lo <= (k) && (k) < hi)
#define BOTH(k) (IN(k) && IN((k) + 1))
#ifndef REP_MASK
#define REP_MASK 0
#endif
#define REPEAT(k) for (int rep_ = 0; rep_ < 1 + ((REP_MASK >> (k)) & 1); ++rep_)
#define PIN() do { int l_ = (int)__builtin_amdgcn_mbcnt_hi(~0u, __builtin_amdgcn_mbcnt_lo(~0u, 0u)); asm volatile("" : "+v"(l_)); F.lane = l_; F.tid = F.wave * 64 + l_; } while (0)
#define XB ((bf16*)(ws + WS_XB))
#define H0 ((bf16*)(ws + WS_H0))
#define CAT0 ((bf16*)(ws + WS_CAT0))
#define Z1 ((bf16*)(ws + WS_X1))
#define HID ((bf16*)(ws + WS_HID))
#define Z2 ((bf16*)(ws + WS_X2))
#define H1 ((bf16*)(ws + WS_H1))
#define CAT1 ((bf16*)(ws + WS_CAT1))
#define Z3 ((bf16*)(ws + WS_X3))
#define X3Q (ws + WS_X3Q)
#define YR ((bf16*)(ws + WS_YR))
#define HIDE ((unsigned char*)args.out)

    if (IN(0)) REPEAT(0) { PIN(); p0_prologue(F, args); if (BOTH(0)) GRID_BAR(); }
    if (IN(1)) REPEAT(1) { pg8::Gemm g{XB, (const bf16*)(ws + WS_WINA), NTOK, NINA, DM}; pg8::P1Order S; S.init(NTOK, NINA, F.G, (int)blockIdx.x); S.memb = (const bf16*)(ws + WS_MEMB); S.wkv = (const bf16*)(ws + WS_WMKV);
        pg8::EpiP1 E{H0, (bf16*)(ws + WS_MEMK), (bf16*)(ws + WS_MEMVT)};
        pg8::gemm_phase<pg8::EpiP1, pg8::P1Order, PG8_ALIGN, PG8_SP2>(F.lds + RING_OFF, g, S, E, F.wave);
        if (BOTH(1)) GRID_BAR(); }
    if (IN(2)) REPEAT(2) { PIN();
        { const float* part = (const float*)((unsigned char*)args.out + DO_PART); float* c1 = (float*)((unsigned char*)args.out + DO_C1); float* c2 = (float*)((unsigned char*)args.out + DO_C2);
          for (int col = F.vcu * (NWAVES * 64) + F.tid; col < NCV; col += F.G * NWAVES * 64) { float a = 0.f, b = 0.f;
#pragma unroll
              for (int kb = 0; kb < 16; ++kb) { a += part[((size_t)kb * NCV + col) * 2]; b += part[((size_t)kb * NCV + col) * 2 + 1]; } c1[col] = a; c2[col] = b; } }
        for (int u = F.vcu; u < NTOK / 128; u += F.G) mixer_a_unit(F, args, u); if (BOTH(2)) GRID_BAR(); }
    if (IN(3)) REPEAT(3) { pg8::Gemm g{CAT0, (const bf16*)(ws + WS_WOUT), NTOK, DM, DM}; pg8::StaticOrder S; S.init(NTOK, DM, F.G, (int)blockIdx.x);
        pg8::EpiZs<2, 0, DO_ST1, 0, true, DO_ZQ> E{XB, Z1, (unsigned char*)args.out, ALPHA, F.lds + EPIP_OFF};
        pg8::gemm_phase<pg8::EpiZs<2, 0, DO_ST1, 0, true, DO_ZQ>, pg8::StaticOrder, true, PG8_SP2>(F.lds + RING_OFF, g, S, E, F.wave);
        if (BOTH(3)) GRID_BAR(); }
    if (IN(5)) REPEAT(5) { pg8::Gemm g{(const bf16*)((unsigned char*)args.out + DO_ZQ), (const bf16*)(ws + WS_WFFGU), NTOK, 2 * DFF, DM / 2}; pg8::StaticOrder S;
        S.init(NTOK, 2 * DFF, F.G, (int)blockIdx.x);
        pg8::EpiSwigluLN<DO_ST1, DO_C1, DO_C2, true, true> E{HID, DFF, (unsigned char*)args.out, 1.0f / (WQ_SCALE * ZQ_SCALE), F.lds + EPIP_OFF, HQ_SCALE};
        pg8::gemm_phase<pg8::EpiSwigluLN<DO_ST1, DO_C1, DO_C2, true, true>, pg8::StaticOrder, PG8_ALIGN, PG8_SP2, 1>(F.lds + RING_OFF, g, S, E, F.wave);
        if (BOTH(5)) GRID_BAR(); }
    if (IN(6)) REPEAT(6) { pg8::Gemm g{HID, (const bf16*)(ws + WS_WFFD), NTOK, DM, DFF / 2}; pg8::StaticOrder S; S.init(NTOK, DM, F.G, (int)blockIdx.x);
        pg8::EpiZs<1, DO_ST1, DO_ST2, 0, true, DO_ZQ, true> E{Z1, Z2, (unsigned char*)args.out, ALPHA, F.lds + EPIP_OFF, 1.0f / (HQ_SCALE * WD_SCALE)};
        pg8::gemm_phase<pg8::EpiZs<1, DO_ST1, DO_ST2, 0, true, DO_ZQ, true>, pg8::StaticOrder, true, PG8_SP2, 1>(F.lds + RING_OFF, g, S, E, F.wave);
        if (BOTH(6)) GRID_BAR(); }
    if (IN(8)) REPEAT(8) { pg8::Gemm g{(const bf16*)((unsigned char*)args.out + DO_ZQ), (const bf16*)(ws + WS_WINB), NTOK, NINB, DM / 2}; pg8::StaticOrder S;
        S.init(NTOK, NINB, F.G, (int)blockIdx.x);
        pg8::EpiLinLN<DO_ST2, DO_C1 + 2 * DFF * 4, DO_C2 + 2 * DFF * 4, true> E{H1, NINB, (unsigned char*)args.out, (const float*)(ws + WS_ROPEC), (const float*)(ws + WS_ROPES), 1.0f / (WQ_SCALE * ZQ_SCALE), F.lds + EPIP_OFF};
        pg8::gemm_phase<pg8::EpiLinLN<DO_ST2, DO_C1 + 2 * DFF * 4, DO_C2 + 2 * DFF * 4, true>, pg8::StaticOrder, PG8_ALIGN, PG8_SP2, 1>(F.lds + RING_OFF, g, S, E, F.wave);
        if (BOTH(8)) GRID_BAR(); }
    if (IN(9)) REPEAT(9) { PIN(); ret_kv_phase(F, args); if (BOTH(9)) GRID_BAR(); }
    if (IN(10)) REPEAT(10) { PIN(); ret_scan(F, args); if (BOTH(10)) GRID_BAR(); }
    if (IN(11)) REPEAT(11) { PIN(); ret_out_phase(F, args); if (BOTH(11)) GRID_BAR(); }
    if (IN(12)) REPEAT(12) { pg8::Gemm g{CAT1, (const bf16*)(ws + WS_WOUT) + (size_t)DM * DM, NTOK, DM, DM}; pg8::StaticOrder S; S.init(NTOK, DM, F.G, (int)blockIdx.x);
        pg8::EpiZs<1, DO_ST2, DO_ST1, DM> E{Z2, Z3, (unsigned char*)args.out, ALPHA, F.lds + EPIP_OFF};
        pg8::gemm_phase<pg8::EpiZs<1, DO_ST2, DO_ST1, DM>, pg8::StaticOrder, true, PG8_SP2>(F.lds + RING_OFF, g, S, E, F.wave);
        if (BOTH(12)) GRID_BAR(); }
    if (IN(13)) REPEAT(13) { PIN(); ln_router(F, args, Z3, inp(F, 14) + 2 * DM, inp(F, 15) + 2 * DM, X3Q); if (BOTH(13)) GRID_BAR(); }
    if (IN(14)) REPEAT(14) { PIN(); route_positions(F, args); if (BOTH(14)) GRID_BAR(); }
    if (IN(15)) REPEAT(15) {
        const int NP = *(const int*)(F.ctl + CW_NP); const int* rowtok = (const int*)(ws + WS_ROWTOK);
        const LAS int* pe = (const LAS int*)(F.lds + EPIP_OFF);
        { PIN(); const int* peg = (const int*)(F.ctl + CW_PE); for (int i = F.tid; i < 272; i += NWAVES * 64) ((LAS int*)(F.lds + EPIP_OFF))[i] = peg[i]; __syncthreads(); }
        const int slo = args.sub_lo, shi = args.sub_hi, plo = args.pass_lo, phi = args.pass_hi;
        for (int p = plo; p < phi; ++p) { const int p0 = p * PASS_PANELS; int npp = NP - p0; if (p + 1 < MAX_PASSES && npp > PASS_PANELS) npp = PASS_PANELS; if (npp <= 0) break;
            if (slo <= 0 && 0 < shi) { pg8::Gemm g{(const bf16*)X3Q, (const bf16*)(ws + WS_WEGU), npp * 256, 2 * DFFE, DM / 2}; pg8::MoeOrder S; S.init(npp * 256, 2 * DFFE, F.G, (int)blockIdx.x); S.pe = pe + p0; S.nbt = 2 * DFFE / 256; S.rowtok = rowtok + p0 * 256;
                pg8::EpiSwiglu8 E{HIDE, DFFE, 1.0f / (WQ_SCALE * ZQ_SCALE)};
                pg8::gemm_phase<pg8::EpiSwiglu8, pg8::MoeOrder, PG8_ALIGN, PG8_SP2, 1, true>(F.lds + RING_OFF, g, S, E, F.wave);
                if (1 < shi) GRID_BAR(); }
            if (slo <= 1 && 1 < shi) { const int npm = npp < PASS_PANELS ? npp : PASS_PANELS;
                { pg8::Gemm g{(const bf16*)HIDE, (const bf16*)(ws + WS_WED), npm * 256, DM, DFFE / 2, 0}; pg8::MoeOrder S; S.init(npm * 256, DM, F.G, (int)blockIdx.x); S.pe = pe + p0; S.nbt = DM / 256; S.rowtok = nullptr;
                  pg8::EpiAct E{YR, DM, 0, p0 * 256};
                  pg8::gemm_phase<pg8::EpiAct, pg8::MoeOrder, PG8_ALIGN, PG8_SP2, 0x78, true>(F.lds + RING_OFF, g, S, E, F.wave); }
                if (npp > PASS_PANELS) {
                  pg8::Gemm g{(const bf16*)HIDE, (const bf16*)(ws + WS_WED), npp * 256, DM, 256, DFFE / 2}; pg8::SplitOrder S; S.init(npp * 256, DM, F.G, (int)blockIdx.x); S.pe = pe + p0; S.pm0 = PASS_PANELS; S.npt = npp - PASS_PANELS;
                  pg8::EpiPart E{(float*)(ws + WS_PARTY), PASS_PANELS};
                  pg8::gemm_phase<pg8::EpiPart, pg8::SplitOrder, PG8_ALIGN, PG8_SP2, 0x78, true>(F.lds + RING_OFF, g, S, E, F.wave); }
                if (MK_SINGLE) GRID_BAR(); }
        }
    }
    if (IN(16)) REPEAT(16) { PIN(); final_rows(F, args); }
#undef IN
#undef BOTH
#undef GRID_BAR
#undef XB
#undef H0
#undef CAT0
#undef Z1
#undef HID
#undef Z2
#undef H1
#undef CAT1
#undef Z3
#undef X3Q
#undef YR
#undef HIDE
}

extern "C" void kernel_launch(void* const* d_in, const int* in_sizes, int n_in, void* d_out, int out_size, void* d_ws, size_t ws_size, hipStream_t stream) {
    static int grid = 0;
    if (grid == 0) {
        if (n_in != 24 || in_sizes[0] != NTOK * DM || out_size != NTOK * DM || ws_size < WS_END) { fprintf(stderr, "kernel_launch: unexpected shapes (n_in %d, in0 %d, out %d, ws %zu < %zu); nothing launched\n", n_in, n_in > 0 ? in_sizes[0] : -1, out_size, ws_size, (size_t)WS_END); grid = -1; return; }
        int dev = 0, cus = 0, per_cu = 0;
        if (hipGetDevice(&dev) != hipSuccess || hipDeviceGetAttribute(&cus, hipDeviceAttributeMultiprocessorCount, dev) != hipSuccess) { grid = -1; return; }
        if (hipFuncSetAttribute((const void*)hyb_fwd, hipFuncAttributeMaxDynamicSharedMemorySize, LDS_BYTES) != hipSuccess) { fprintf(stderr, "kernel_launch: hipFuncSetAttribute failed\n"); grid = -1; return; }
        if (hipOccupancyMaxActiveBlocksPerMultiprocessor(&per_cu, (const void*)hyb_fwd, NWAVES * 64, LDS_BYTES) != hipSuccess || per_cu < 1)
            fprintf(stderr, "kernel_launch: note: occupancy query reports %d workgroups per CU\n", per_cu);
        (void)hipGetLastError();
        grid = cus;
    }
    if (grid < 0) return;
    if (hipMemsetAsync((char*)d_ws + WS_CTL, 0, CTL_ZERO_BYTES, stream) != hipSuccess) { fprintf(stderr, "kernel_launch: hipMemsetAsync failed\n"); return; }
    Args a{};
    for (int i = 0; i < 24; ++i) a.in[i] = (const float*)d_in[i];
    a.out = (float*)d_out; a.ws = (unsigned char*)d_ws;
#if MK_SINGLE
    a.ph_lo = 0; a.ph_hi = N_PHASES; a.pass_lo = 0; a.pass_hi = MAX_PASSES; a.sub_lo = 0; a.sub_hi = 2; a.li = 0;
    hipLaunchKernelGGL(hyb_fwd, dim3(grid), dim3(NWAVES * 64), LDS_BYTES, stream, a);
#else
    for (int ph = 0; ph < N_PHASES; ++ph) {
        a.ph_lo = ph; a.ph_hi = ph + 1; a.li = 0;
        if (ph != 15) { a.pass_lo = 0; a.pass_hi = 0; a.sub_lo = 0; a.sub_hi = 0; hipLaunchKernelGGL(hyb_fwd, dim3(grid), dim3(NWAVES * 64), LDS_BYTES, stream, a); }
        else for (int p = 0; p < MAX_PASSES; ++p) for (int s = 0; s < 2; ++s) { a.pass_lo = p; a.pass_hi = p + 1; a.sub_lo = s; a.sub_hi = s + 1; hipLaunchKernelGGL(hyb_fwd, dim3(grid), dim3(NWAVES * 64), LDS_BYTES, stream, a); }
    }
#endif
    const hipError_t le = hipPeekAtLastError();
    if (le != hipSuccess) fprintf(stderr, "kernel_launch: launch failed: %s\n", hipGetErrorName(le));
}
```
